# Optimizing an MI355X kernel written in HIP

```python
import math
import jax
import jax.numpy as jnp
from jax import lax
import numpy as np

D_MODEL = 1024
BATCH = 8
SEQ = 2048
DEPTH = 4
DEC_BATCH = 128
DEC_SEQ = 4
PAST_LEN = 8192
PAGE_SIZE = 128

N_MIXERS = 3
N_SWA = (DEPTH + 2) // 3
N_GDN = (DEPTH + 1) // 3
N_HGRN = DEPTH // 3

SWA_HEAD_DIM = 64
SWA_HEADS = D_MODEL // SWA_HEAD_DIM
SWA_KV_HEADS = SWA_HEADS // 4
SWA_GROUP = SWA_HEADS // SWA_KV_HEADS
WINDOW = 128
ROT_DIM = SWA_HEAD_DIM // 4
ROPE_THETA = 500000.0
SWA_IN = (SWA_HEADS + 2 * SWA_KV_HEADS) * SWA_HEAD_DIM

GDN_HEAD_DIM = 128
GDN_QK_HEADS = D_MODEL // GDN_HEAD_DIM
GDN_V_HEADS = 2 * GDN_QK_HEADS
GDN_KEY_DIM = GDN_QK_HEADS * GDN_HEAD_DIM
GDN_V_DIM = GDN_V_HEADS * GDN_HEAD_DIM
GDN_CONV_DIM = 2 * GDN_KEY_DIM + GDN_V_DIM
GDN_CONV = 4
GDN_CHUNK = 64
GDN_IN = GDN_CONV_DIM + GDN_V_DIM + 2 * GDN_V_HEADS

HG_HEAD_DIM = 128
HG_HEADS = D_MODEL // HG_HEAD_DIM
HG_DIM = HG_HEADS * HG_HEAD_DIM
HG_CHUNK = 32

D_FF = ((8 * D_MODEL // 3 + 127) // 128) * 128
NORM_EPS = 1e-6
NEG_INF = -1e30

kernel_name = "hybrid_swa_gdn_hgrn2_macaron_step"


def _rmsnorm(x, g):
    xf = x.astype(jnp.float32)
    y = xf * lax.rsqrt(jnp.mean(xf * xf, axis=-1, keepdims=True) + NORM_EPS)
    return (y * g.astype(jnp.float32)).astype(x.dtype)


def _l2norm(x):
    return x * lax.rsqrt(jnp.sum(x * x, axis=-1, keepdims=True) + NORM_EPS)


def _swiglu(h, w_in, w_out):
    gate, up = jnp.split(h @ w_in, 2, axis=-1)
    return (jax.nn.silu(gate) * up) @ w_out


def _rope_partial(x, pos):
    half = ROT_DIM // 2
    inv_freq = ROPE_THETA ** (-jnp.arange(0, ROT_DIM, 2, dtype=jnp.float32) / ROT_DIM)
    ang = pos.astype(jnp.float32)[:, None] * inv_freq[None, :]
    cos = jnp.cos(ang)[None, :, None, :]
    sin = jnp.sin(ang)[None, :, None, :]
    xr = x[..., :ROT_DIM].astype(jnp.float32)
    x1, x2 = xr[..., :half], xr[..., half:]
    rot = jnp.concatenate([x1 * cos - x2 * sin, x2 * cos + x1 * sin], axis=-1)
    return jnp.concatenate([rot.astype(x.dtype), x[..., ROT_DIM:]], axis=-1)


def _sink_attention(q, k, v, mask, sinks):
    s = jnp.einsum('...qhgd,...khd->...hgqk', q.astype(jnp.float32), k.astype(jnp.float32))
    s = jnp.where(mask, s * (SWA_HEAD_DIM ** -0.5), NEG_INF)
    sink = sinks.astype(jnp.float32).reshape(SWA_KV_HEADS, SWA_GROUP, 1, 1)
    m = jnp.maximum(jnp.max(s, axis=-1, keepdims=True), sink)
    p = jnp.exp(s - m)
    denom = jnp.sum(p, axis=-1, keepdims=True) + jnp.exp(sink - m)
    return jnp.einsum('...hgqk,...khd->...qhgd', p / denom, v.astype(jnp.float32))


def _swa_mixer(h, pos0, w_in, w_out, sinks, cache_k, cache_v):
    b, l, _ = h.shape
    q, k, v = jnp.split(h @ w_in, [SWA_HEADS * SWA_HEAD_DIM, (SWA_HEADS + SWA_KV_HEADS) * SWA_HEAD_DIM], axis=-1)
    pos = pos0 + jnp.arange(l)
    q = _rope_partial(q.reshape(b, l, SWA_HEADS, SWA_HEAD_DIM), pos)
    k = _rope_partial(k.reshape(b, l, SWA_KV_HEADS, SWA_HEAD_DIM), pos)
    v = v.reshape(b, l, SWA_KV_HEADS, SWA_HEAD_DIM)
    q = q.reshape(b, l, SWA_KV_HEADS, SWA_GROUP, SWA_HEAD_DIM)
    if cache_k is None:
        nb = l // WINDOW
        qb = q.reshape(b, nb, WINDOW, SWA_KV_HEADS, SWA_GROUP, SWA_HEAD_DIM)
        kb = k.reshape(b, nb, WINDOW, SWA_KV_HEADS, SWA_HEAD_DIM)
        vb = v.reshape(b, nb, WINDOW, SWA_KV_HEADS, SWA_HEAD_DIM)
        padw = ((0, 0), (1, 0), (0, 0), (0, 0), (0, 0))
        kk = jnp.concatenate([jnp.pad(kb, padw)[:, :-1], kb], axis=2)
        vv = jnp.concatenate([jnp.pad(vb, padw)[:, :-1], vb], axis=2)
        qi = jnp.arange(WINDOW)[:, None]
        kj = jnp.arange(2 * WINDOW)[None, :]
        d = qi + WINDOW - kj
        band = (d >= 0) & (d < WINDOW)
        valid = (jnp.arange(nb)[:, None, None] > 0) | (kj[None] >= WINDOW)
        mask = (band[None] & valid)[None, :, None, None]
        o = _sink_attention(qb, kk, vv, mask, sinks).reshape(b, l, SWA_HEADS * SWA_HEAD_DIM)
        k_buf, v_buf = k[:, l - WINDOW:], v[:, l - WINDOW:]
    else:
        kk = jnp.concatenate([cache_k.astype(k.dtype), k], axis=1)
        vv = jnp.concatenate([cache_v.astype(v.dtype), v], axis=1)
        qi = jnp.arange(l)[:, None]
        kj = jnp.arange(WINDOW + l)[None, :]
        d = qi + WINDOW - kj
        mask = (d >= 0) & (d < WINDOW)
        o = _sink_attention(q, kk, vv, mask, sinks).reshape(b, l, SWA_HEADS * SWA_HEAD_DIM)
        k_buf, v_buf = kk[:, l:], vv[:, l:]
    return o.astype(h.dtype) @ w_out, k_buf, v_buf


def _to_chunks(x, c, n):
    bsz, l = x.shape[:2]
    x = jnp.pad(x, [(0, 0), (0, n * c - l)] + [(0, 0)] * (x.ndim - 2))
    x = x.reshape((bsz, n, c) + x.shape[2:])
    return jnp.swapaxes(jnp.moveaxis(x, 1, 0), 2, 3)


def _from_chunks(o, l):
    o = jnp.moveaxis(jnp.swapaxes(o, 2, 3), 0, 1)
    return o.reshape((o.shape[0], -1) + o.shape[3:])[:, :l]


def _gated_delta_rule(q, k, v, g, beta, s0):
    l = q.shape[1]
    c = min(GDN_CHUNK, l)
    n = -(-l // c)
    dv = v.shape[-1]
    incl = jnp.tril(jnp.ones((c, c), dtype=bool))
    strict = jnp.tril(jnp.ones((c, c), dtype=bool), -1)
    eye = jnp.eye(c, dtype=jnp.float32)

    def step(s, xs):
        qc, kc, vc, gc, bc = xs
        gcum = jnp.cumsum(gc, axis=-1)
        decay = jnp.exp(jnp.where(incl, gcum[..., :, None] - gcum[..., None, :], -jnp.inf))
        kb = kc * bc[..., None]
        a = jnp.where(strict, jnp.einsum('bhid,bhjd->bhij', kb, kc) * decay, 0.0)
        rhs = jnp.concatenate([vc * bc[..., None], kb * jnp.exp(gcum)[..., None]], axis=-1)
        sol = lax.linalg.triangular_solve(eye + a, rhs, left_side=True, lower=True, unit_diagonal=True)
        u, w = sol[..., :dv], sol[..., dv:]
        v_new = u - jnp.einsum('bhik,bhkv->bhiv', w, s)
        attn = jnp.einsum('bhid,bhjd->bhij', qc, kc) * decay
        o = (jnp.einsum('bhik,bhkv->bhiv', qc * jnp.exp(gcum)[..., None], s)
             + jnp.einsum('bhij,bhjv->bhiv', attn, v_new))
        g_last = gcum[..., -1:]
        s = (s * jnp.exp(g_last)[..., None]
             + jnp.einsum('bhik,bhiv->bhkv', kc * jnp.exp(g_last - gcum)[..., None], v_new))
        return s, o

    xs = (_to_chunks(q, c, n), _to_chunks(k, c, n), _to_chunks(v, c, n),
          _to_chunks(g, c, n), _to_chunks(beta, c, n))
    s_fin, o = lax.scan(step, s0, xs)
    return _from_chunks(o, l), s_fin


def _gated_linear_recurrence(q, k, v, log_f, s0):
    l = q.shape[1]
    c = min(HG_CHUNK, l)
    n = -(-l // c)
    incl = jnp.tril(jnp.ones((c, c), dtype=bool))[:, :, None]

    def step(s, xs):
        qc, kc, vc, lc = xs
        bcum = jnp.cumsum(lc, axis=2)
        diff = bcum[:, :, :, None, :] - bcum[:, :, None, :, :]
        decay = jnp.exp(jnp.where(incl, diff, -jnp.inf))
        attn = jnp.einsum('bhid,bhjd,bhijd->bhij', qc, kc, decay)
        o = (jnp.einsum('bhik,bhkv->bhiv', qc * jnp.exp(bcum), s)
             + jnp.einsum('bhij,bhjv->bhiv', attn, vc))
        b_last = bcum[:, :, -1:]
        s = (s * jnp.exp(bcum[:, :, -1])[..., None]
             + jnp.einsum('bhjk,bhjv->bhkv', kc * jnp.exp(b_last - bcum), vc))
        return s, o

    xs = (_to_chunks(q, c, n), _to_chunks(k, c, n), _to_chunks(v, c, n), _to_chunks(log_f, c, n))
    s_fin, o = lax.scan(step, s0, xs)
    return _from_chunks(o, l), s_fin


def _gdn_mixer(h, w_in, conv_w, a_log, dt_bias, norm_g, w_out, s0, conv0):
    b, l, _ = h.shape
    qkv, z, beta_in, a_in = jnp.split(
        h @ w_in, [GDN_CONV_DIM, GDN_CONV_DIM + GDN_V_DIM, GDN_CONV_DIM + GDN_V_DIM + GDN_V_HEADS], axis=-1)
    if conv0 is None:
        conv0 = jnp.zeros((b, GDN_CONV - 1, GDN_CONV_DIM), h.dtype)
    xp = jnp.concatenate([conv0.astype(h.dtype), qkv], axis=1)
    acc = xp[:, 0:l] * conv_w[0]
    for t in range(1, GDN_CONV):
        acc = acc + xp[:, t:t + l] * conv_w[t]
    qkv_c = jax.nn.silu(acc.astype(jnp.float32))
    q, k, v = jnp.split(qkv_c, [GDN_KEY_DIM, 2 * GDN_KEY_DIM], axis=-1)
    rep = GDN_V_HEADS // GDN_QK_HEADS
    q = jnp.repeat(_l2norm(q.reshape(b, l, GDN_QK_HEADS, GDN_HEAD_DIM)), rep, axis=2) * (GDN_HEAD_DIM ** -0.5)
    k = jnp.repeat(_l2norm(k.reshape(b, l, GDN_QK_HEADS, GDN_HEAD_DIM)), rep, axis=2)
    v = v.reshape(b, l, GDN_V_HEADS, GDN_HEAD_DIM)
    beta = jax.nn.sigmoid(beta_in.astype(jnp.float32))
    g = -jnp.exp(a_log.astype(jnp.float32)) * jax.nn.softplus(a_in.astype(jnp.float32) + dt_bias.astype(jnp.float32))
    if s0 is None:
        s_init = jnp.zeros((b, GDN_V_HEADS, GDN_HEAD_DIM, GDN_HEAD_DIM), jnp.float32)
    else:
        s_init = s0.astype(jnp.float32)
    o, s_fin = _gated_delta_rule(q, k, v, g, beta, s_init)
    o = _rmsnorm(o, norm_g) * jax.nn.silu(z.astype(jnp.float32).reshape(b, l, GDN_V_HEADS, GDN_HEAD_DIM))
    y = o.reshape(b, l, GDN_V_DIM).astype(h.dtype) @ w_out
    return y, s_fin.astype(h.dtype), xp[:, l:]


def _hgrn_mixer(h, lb, w_in, norm_g, w_out, s0):
    b, l, _ = h.shape
    shp = (b, l, HG_HEADS, HG_HEAD_DIM)
    q, fz, i_in, gate = jnp.split((h @ w_in).astype(jnp.float32), 4, axis=-1)
    lb = lb.reshape(HG_HEADS, HG_HEAD_DIM)
    fz = fz.reshape(shp)
    log_f = jnp.logaddexp(jnp.log(lb), jnp.log1p(-lb) + jax.nn.log_sigmoid(fz))
    k = (1.0 - lb) * jax.nn.sigmoid(-fz)
    q = jax.nn.silu(q).reshape(shp)
    v = i_in.reshape(shp)
    if s0 is None:
        s_init = jnp.zeros((b, HG_HEADS, HG_HEAD_DIM, HG_HEAD_DIM), jnp.float32)
    else:
        s_init = s0.astype(jnp.float32)
    o, s_fin = _gated_linear_recurrence(q, k, v, log_f, s_init)
    o = _rmsnorm(o, norm_g) * jax.nn.silu(gate.reshape(shp))
    y = o.reshape(b, l, HG_DIM).astype(h.dtype) @ w_out
    return y, s_fin.astype(h.dtype)


def _trunk(x, pos0, cache_swa_k, cache_swa_v, state_gdn, state_gdn_conv, state_hgrn, w):
    new_k, new_v, new_gdn, new_conv, new_hgrn = [], [], [], [], []
    p_lb = jax.nn.softmax(w['hgrn_lb_logits'].astype(jnp.float32), axis=0)
    lb_all = jnp.cumsum(p_lb, axis=0) - p_lb[:1]
    for i in range(DEPTH):
        kind, j = i % N_MIXERS, i // N_MIXERS
        x = x + 0.5 * _swiglu(_rmsnorm(x, w['norm_ffn'][i, 0]), w['ffn_w_in'][i, 0], w['ffn_w_out'][i, 0])
        h = _rmsnorm(x, w['norm_mix'][i])
        if kind == 0:
            y, kb, vb = _swa_mixer(h, pos0, w['swa_w_in'][j], w['swa_w_out'][j], w['swa_sinks'][j],
                                   None if cache_swa_k is None else cache_swa_k[j],
                                   None if cache_swa_v is None else cache_swa_v[j])
            new_k.append(kb)
            new_v.append(vb)
        elif kind == 1:
            y, s_new, c_new = _gdn_mixer(h, w['gdn_w_in'][j], w['gdn_conv_w'][j], w['gdn_a_log'][j],
                                         w['gdn_dt_bias'][j], w['gdn_norm'][j], w['gdn_w_out'][j],
                                         None if state_gdn is None else state_gdn[j],
                                         None if state_gdn_conv is None else state_gdn_conv[j])
            new_gdn.append(s_new)
            new_conv.append(c_new)
        else:
            y, s_new = _hgrn_mixer(h, lb_all[i], w['hgrn_w_in'][j], w['hgrn_norm'][j], w['hgrn_w_out'][j],
                                   None if state_hgrn is None else state_hgrn[j])
            new_hgrn.append(s_new)
        x = x + y
        x = x + 0.5 * _swiglu(_rmsnorm(x, w['norm_ffn'][i, 1]), w['ffn_w_in'][i, 1], w['ffn_w_out'][i, 1])
    y_out = _rmsnorm(x, w['final_norm'])
    return (y_out, jnp.stack(new_k), jnp.stack(new_v), jnp.stack(new_gdn),
            jnp.stack(new_conv), jnp.stack(new_hgrn))


def setup_inputs(seed: int = 0) -> dict:
    key = jax.random.key(seed)
    ks = jax.random.split(key, 32)

    def nrm(i, shape, scale):
        return scale * jax.random.normal(ks[i], shape, jnp.float32)

    dt = jnp.exp(jax.random.uniform(ks[20], (N_GDN, GDN_V_HEADS), jnp.float32,
                                    math.log(1e-3), math.log(1e-1)))
    return {
        'x_prompt': nrm(0, (BATCH, SEQ, D_MODEL), 1.0),
        'x_sample': nrm(1, (DEC_BATCH, DEC_SEQ, D_MODEL), 1.0),
        'cache_swa_k': nrm(2, (N_SWA, DEC_BATCH, WINDOW, SWA_KV_HEADS, SWA_HEAD_DIM), 1.0),
        'cache_swa_v': nrm(3, (N_SWA, DEC_BATCH, WINDOW, SWA_KV_HEADS, SWA_HEAD_DIM), 1.0),
        'state_gdn': nrm(4, (N_GDN, DEC_BATCH, GDN_V_HEADS, GDN_HEAD_DIM, GDN_HEAD_DIM), 0.1),
        'state_gdn_conv': nrm(5, (N_GDN, DEC_BATCH, GDN_CONV - 1, GDN_CONV_DIM), 1.0),
        'state_hgrn': nrm(6, (N_HGRN, DEC_BATCH, HG_HEADS, HG_HEAD_DIM, HG_HEAD_DIM), 0.3),
        'norm_ffn': 1.0 + nrm(7, (DEPTH, 2, D_MODEL), 0.02),
        'ffn_w_in': nrm(8, (DEPTH, 2, D_MODEL, 2 * D_FF), D_MODEL ** -0.5),
        'ffn_w_out': nrm(9, (DEPTH, 2, D_FF, D_MODEL), D_FF ** -0.5),
        'norm_mix': 1.0 + nrm(10, (DEPTH, D_MODEL), 0.02),
        'swa_w_in': nrm(11, (N_SWA, D_MODEL, SWA_IN), D_MODEL ** -0.5),
        'swa_w_out': nrm(12, (N_SWA, SWA_HEADS * SWA_HEAD_DIM, D_MODEL), (SWA_HEADS * SWA_HEAD_DIM) ** -0.5),
        'swa_sinks': nrm(13, (N_SWA, SWA_HEADS), 0.5),
        'gdn_w_in': nrm(14, (N_GDN, D_MODEL, GDN_IN), D_MODEL ** -0.5),
        'gdn_conv_w': nrm(15, (N_GDN, GDN_CONV, GDN_CONV_DIM), 0.5),
        'gdn_a_log': jnp.log(jax.random.uniform(ks[21], (N_GDN, GDN_V_HEADS), jnp.float32, 1.0, 16.0)),
        'gdn_dt_bias': dt + jnp.log(-jnp.expm1(-dt)),
        'gdn_norm': 1.0 + nrm(16, (N_GDN, GDN_HEAD_DIM), 0.02),
        'gdn_w_out': nrm(17, (N_GDN, GDN_V_DIM, D_MODEL), GDN_V_DIM ** -0.5),
        'hgrn_w_in': nrm(18, (N_HGRN, D_MODEL, 4 * HG_DIM), D_MODEL ** -0.5),
        'hgrn_lb_logits': nrm(19, (DEPTH, HG_DIM), 0.5),
        'hgrn_norm': 1.0 + nrm(22, (N_HGRN, HG_HEAD_DIM), 0.02),
        'hgrn_w_out': nrm(23, (N_HGRN, HG_DIM, D_MODEL), HG_DIM ** -0.5),
        'final_norm': 1.0 + nrm(24, (D_MODEL,), 0.02),
    }


def reference(x_prompt, x_sample, cache_swa_k, cache_swa_v, state_gdn, state_gdn_conv, state_hgrn,
              norm_ffn, ffn_w_in, ffn_w_out, norm_mix, swa_w_in, swa_w_out, swa_sinks,
              gdn_w_in, gdn_conv_w, gdn_a_log, gdn_dt_bias, gdn_norm, gdn_w_out,
              hgrn_w_in, hgrn_lb_logits, hgrn_norm, hgrn_w_out, final_norm):
    w = dict(norm_ffn=norm_ffn, ffn_w_in=ffn_w_in, ffn_w_out=ffn_w_out, norm_mix=norm_mix,
             swa_w_in=swa_w_in, swa_w_out=swa_w_out, swa_sinks=swa_sinks,
             gdn_w_in=gdn_w_in, gdn_conv_w=gdn_conv_w, gdn_a_log=gdn_a_log, gdn_dt_bias=gdn_dt_bias,
             gdn_norm=gdn_norm, gdn_w_out=gdn_w_out, hgrn_w_in=hgrn_w_in, hgrn_lb_logits=hgrn_lb_logits,
             hgrn_norm=hgrn_norm, hgrn_w_out=hgrn_w_out, final_norm=final_norm)
    y_prompt, pk, pv, pg, pc, ph = _trunk(x_prompt, 0, None, None, None, None, None, w)
    y_sample, sk, sv, sg, sc, sh = _trunk(x_sample, PAST_LEN, cache_swa_k, cache_swa_v,
                                          state_gdn, state_gdn_conv, state_hgrn, w)
    return (y_prompt, y_sample, pk, pv, pg, pc, ph, sk, sv, sg, sc, sh)
```

```cpp
#include <hip/hip_runtime.h>
#include <hip/hip_cooperative_groups.h>
#include <cstdio>
#include <cmath>
namespace cg = cooperative_groups;
namespace pg8 {
#define PG8_LAS __attribute__((address_space(3)))
typedef unsigned short bf16_t;
typedef short bf16x8 __attribute__((ext_vector_type(8)));
typedef float f32x4 __attribute__((ext_vector_type(4)));
typedef unsigned u32x4 __attribute__((ext_vector_type(4)));
constexpr int BM = 256, BK = 64, HALF = 128, HTB = HALF * BK * 2  , STAGE_BYTES = 8 * HTB, NXCD = 8, WGM = 8;

__host__ __device__ __forceinline__ int lds_byte(int r, int c) { const int st = (r >> 4) * 2 + (c >> 5), rr = r & 15, cc = c & 31, ob = rr * 64 + cc * 2; return st * 1024 + (ob ^ (((ob >> 9) & 1) << 5)); }
__host__ __device__ __forceinline__ void stage_rc(int b, int& R, int& C) { const int st = b / 1024, sb = b % 1024, swz = sb ^ (((sb >> 9) & 1) << 5); R = (st >> 1) * 16 + swz / 64; C = (st & 1) * 32 + (swz % 64) / 2; }
__host__ __device__ __forceinline__ int perm32(int rho) { const int n = rho >> 4, i = rho & 15; return 8 * (i >> 2) + 4 * n + (i & 3); }

struct Unit { int pm, pn; };
struct Gemm { const bf16_t* A; const bf16_t* Bt; int M, N, K; };

struct StaticOrder {
    int nM, nN, nwg, G, c;
    __host__ __device__ void init(int M, int N, int G_, int c_) { nM = M / BM; nN = N / BM; nwg = nM * nN; G = G_; c = c_; }
    __host__ __device__ bool next(int i, Unit& u) const {
        const long L = (long)i * G + c; if (L >= nwg) return false;
        int wgid = (int)L; { const int q = nwg / NXCD, r = nwg % NXCD, xcd = wgid % NXCD, off = wgid / NXCD; wgid = (xcd < r ? xcd * (q + 1) : r * (q + 1) + (xcd - r) * q) + off; }
        const int nig = WGM * nN, gid = wgid / nig, fm = gid * WGM, gsz = (nM - fm) < WGM ? (nM - fm) : WGM;
        u.pm = fm + ((wgid % nig) % gsz); u.pn = (wgid % nig) / gsz; return true;
    }
    __device__ __forceinline__ void a_ready(const Unit&) const {}
    __device__ __forceinline__ void done(const Unit&) const {}
};
typedef __bf16 bf16v2_t __attribute__((ext_vector_type(2)));
__device__ __forceinline__ unsigned cvt_pk_bf16(float lo, float hi) { float __attribute__((ext_vector_type(2))) v = {lo, hi}; return __builtin_bit_cast(unsigned, __builtin_convertvector(v, bf16v2_t)); }
typedef float f32x2 __attribute__((ext_vector_type(2)));
template <class Epi, class Sched, bool STAMP = false>
__device__ __forceinline__ void gemm_phase(PG8_LAS unsigned char* lds, const Gemm g, const Sched& S, const Epi& E, unsigned long long* stamps) {
    int tid_ = threadIdx.x; asm volatile("" : "+v"(tid_)); const int tid = tid_, wid = __builtin_amdgcn_readfirstlane(tid >> 6), lane = tid & 63, wr = wid >> 2, wc = wid & 3, fr = lane & 15, fq = lane >> 4;
    const int K = g.K, nt = K / BK;
    int ts_lo = 0, ts_hi = 0, nts = 0; const unsigned long long rt_entry = STAMP ? (unsigned long long)wall_clock64() : 0ull;
#define PG8_STAMP() do { if (STAMP && wid == 0 && nts < 64) { const unsigned long long _c = (unsigned long long)clock64(); \
        ts_lo = (lane == nts) ? (int)(unsigned)_c : ts_lo; ts_hi = (lane == nts) ? (int)(unsigned)(_c >> 32) : ts_hi; ++nts; } } while (0)
    PG8_STAMP();
    unsigned voffA[2], voffB[2];
#pragma unroll
    for (int i = 0; i < 2; ++i) { int R, C; stage_rc(tid * 16 + i * 8192, R, C); const int Rb = Epi::PERM ? ((R & ~31) + perm32(R & 31)) : R;
        voffA[i] = (unsigned)(R * K + C) * 2u; voffB[i] = (unsigned)(Rb * K + C) * 2u; }
    const size_t kstep = (size_t)(BK * 2);
    const size_t hstep = (size_t)HALF * K * 2;
    const size_t tstep = 2 * hstep;
    const unsigned ldsw = (unsigned)wid * 1024u;
    const int aoff = lds_byte(wr * 64 + fr, fq * 8), boff = lds_byte(wc * 32 + fr, fq * 8);
#define PG8_SA(b, h) (((b) * 2 + (h)) * HTB)
#define PG8_SB(b, h) ((4 + (b) * 2 + (h)) * HTB)
#define PG8_STAGE(bufoff, gbase, voff) do { _Pragma("unroll") for (int _i = 0; _i < 2; ++_i) \
        __builtin_amdgcn_global_load_lds((const unsigned*)((const char*)(gbase) + (voff)[_i]), (PG8_LAS unsigned*)(lds + (bufoff) + ldsw + _i * 8192), 16, 0, 0); } while (0)
#define PG8_LDA(dst, b, h) do { _Pragma("unroll") for (int m = 0; m < 4; ++m) _Pragma("unroll") for (int k = 0; k < 2; ++k) dst[m][k] = *(const PG8_LAS bf16x8*)(lds + PG8_SA(b, h) + aoff + m * 2048 + k * 1024); } while (0)
#define PG8_LDB(dst, b, h) do { _Pragma("unroll") for (int n = 0; n < 2; ++n) _Pragma("unroll") for (int k = 0; k < 2; ++k) dst[n][k] = *(const PG8_LAS bf16x8*)(lds + PG8_SB(b, h) + boff + n * 2048 + k * 1024); } while (0)
#define PG8_MMA(ai, bj, At, Bt) do { __builtin_amdgcn_s_setprio(1); _Pragma("unroll") for (int m = 0; m < 4; ++m) _Pragma("unroll") for (int n = 0; n < 2; ++n) _Pragma("unroll") for (int k = 0; k < 2; ++k) \
        acc[ai][bj][m][n] = __builtin_amdgcn_mfma_f32_16x16x32_bf16(Bt[n][k], At[m][k], acc[ai][bj][m][n], 0, 0, 0); __builtin_amdgcn_s_setprio(0); } while (0)
#define PG8_WAIT_V(n) asm volatile("s_waitcnt vmcnt(" #n ")" ::: "memory")
#define PG8_WAIT_L(n) asm volatile("s_waitcnt lgkmcnt(" #n ")" ::: "memory")
#define PG8_BAR __builtin_amdgcn_s_barrier()
#define PG8_SCHED __builtin_amdgcn_sched_barrier(0)
    Unit cur, nxt; int ui = 0;
    if (!S.next(0, cur)) return;
    f32x4 acc[2][2][4][2];
#pragma unroll
    for (int a = 0; a < 2; ++a)
#pragma unroll
        for (int b = 0; b < 2; ++b)
#pragma unroll
            for (int m = 0; m < 4; ++m)
#pragma unroll
                for (int n = 0; n < 2; ++n) acc[a][b][m][n] = (f32x4){0.f, 0.f, 0.f, 0.f};
    bf16x8 At[4][2], B0[2][2], B1[2][2];
    const char* cA = (const char*)g.A + (size_t)cur.pm * tstep; const char* cB = (const char*)g.Bt + (size_t)cur.pn * tstep;
    S.a_ready(cur);
    PG8_STAGE(PG8_SB(0, 0), cB, voffB); PG8_STAGE(PG8_SA(0, 0), cA, voffA); PG8_STAGE(PG8_SB(0, 1), cB + hstep, voffB); PG8_STAGE(PG8_SA(0, 1), cA + hstep, voffA);
    if (wr == 1) PG8_BAR;
    PG8_WAIT_V(4); PG8_BAR;
    PG8_STAGE(PG8_SB(1, 0), cB + kstep, voffB); PG8_STAGE(PG8_SA(1, 0), cA + kstep, voffA); PG8_STAGE(PG8_SB(1, 1), cB + hstep + kstep, voffB);
    PG8_WAIT_V(6); PG8_BAR;
    PG8_STAMP();
    for (;;) {
        const bool has_next = S.next(ui + 1, nxt);
        const char* nA = has_next ? (const char*)g.A + (size_t)nxt.pm * tstep : cA; const char* nB = has_next ? (const char*)g.Bt + (size_t)nxt.pn * tstep : cB;
        for (int t = 0; t < nt; t += 2) {
            const bool last = (t == nt - 2);
            const char* a1 = cA + (size_t)(t + 1) * kstep;
            const char* a2 = last ? nA : cA + (size_t)(t + 2) * kstep; const char* b2 = last ? nB : cB + (size_t)(t + 2) * kstep;
            const char* a3 = a2 + kstep; const char* b3 = b2 + kstep;
            if (last && has_next) S.a_ready(nxt);
            PG8_LDB(B0, 0, 0); PG8_SCHED; PG8_LDA(At, 0, 0); PG8_STAGE(PG8_SA(1, 1), a1 + hstep, voffA);
            PG8_WAIT_L(8); PG8_BAR; PG8_WAIT_L(0); PG8_MMA(0, 0, At, B0); PG8_BAR; PG8_SCHED;
            PG8_LDB(B1, 0, 1); PG8_STAGE(PG8_SB(0, 0), b2, voffB);
            PG8_BAR; PG8_WAIT_L(0); PG8_MMA(0, 1, At, B1); PG8_BAR;
            PG8_LDA(At, 0, 1); PG8_STAGE(PG8_SA(0, 0), a2, voffA);
            PG8_BAR; PG8_WAIT_L(0); PG8_MMA(1, 0, At, B0); PG8_BAR; PG8_SCHED;
            PG8_STAGE(PG8_SB(0, 1), b2 + hstep, voffB);
            PG8_WAIT_V(6); PG8_BAR; PG8_MMA(1, 1, At, B1); PG8_BAR;
            PG8_LDB(B0, 1, 0); PG8_SCHED; PG8_LDA(At, 1, 0); PG8_STAGE(PG8_SA(0, 1), a2 + hstep, voffA);
            PG8_WAIT_L(8); PG8_BAR; PG8_WAIT_L(0); PG8_MMA(0, 0, At, B0); PG8_BAR; PG8_SCHED;
            PG8_LDB(B1, 1, 1); PG8_STAGE(PG8_SB(1, 0), b3, voffB);
            PG8_BAR; PG8_WAIT_L(0); PG8_MMA(0, 1, At, B1); PG8_BAR;
            PG8_LDA(At, 1, 1); PG8_STAGE(PG8_SA(1, 0), a3, voffA);
            PG8_BAR; PG8_WAIT_L(0); PG8_MMA(1, 0, At, B0); PG8_BAR; PG8_SCHED;
            PG8_STAGE(PG8_SB(1, 1), b3 + hstep, voffB);
            PG8_WAIT_V(6); PG8_BAR; PG8_MMA(1, 1, At, B1); PG8_BAR;
        }
        PG8_STAMP();
        if constexpr (!Epi::AFTER_DRAIN) { E(acc, cur, wr, wc, fr, fq); S.done(cur); }
        PG8_STAMP();
        if (!has_next) break;
#pragma unroll
        for (int a = 0; a < 2; ++a)
#pragma unroll
            for (int b = 0; b < 2; ++b)
#pragma unroll
                for (int m = 0; m < 4; ++m)
#pragma unroll
                    for (int n = 0; n < 2; ++n) acc[a][b][m][n] = (f32x4){0.f, 0.f, 0.f, 0.f};
        cur = nxt; cA = nA; cB = nB; ++ui;
    }
    PG8_WAIT_V(0);
    if (wr == 0) PG8_BAR;
    PG8_BAR;
    if constexpr (Epi::AFTER_DRAIN) { E.fused(acc, cur, wr, wc, fr, fq, lds, wid, lane); S.done(cur); }
    PG8_STAMP();
    if (STAMP && wid == 0) { stamps[lane] = lane < nts ? (((unsigned long long)(unsigned)ts_hi << 32) | (unsigned)ts_lo) : 0ull;
        if (lane == 62) stamps[62] = rt_entry; if (lane == 63) stamps[63] = (unsigned long long)wall_clock64(); }
#undef PG8_STAMP
#undef PG8_SA
#undef PG8_SB
#undef PG8_STAGE
#undef PG8_LDA
#undef PG8_LDB
#undef PG8_MMA
#undef PG8_WAIT_V
#undef PG8_WAIT_L
#undef PG8_BAR
#undef PG8_SCHED
}
}

using pg8::bf16_t; using pg8::bf16x8; using pg8::f32x4; using pg8::u32x4; using pg8::Unit; using pg8::cvt_pk_bf16;
typedef unsigned u32x2 __attribute__((ext_vector_type(2)));
typedef short bf16x4 __attribute__((ext_vector_type(4)));

#ifndef NLAYERS
#define NLAYERS 4
#endif
#ifndef MULTI_LAUNCH
#define MULTI_LAUNCH 0
#endif

constexpr int M_TOK = 16896, MP = 16384, DM = 1024, DFF = 2816;
constexpr float EPS = 1e-6f;
constexpr int LDS_BYTES = 131072;

constexpr size_t OUT_Y = 0;
constexpr size_t OUT_PK = (size_t)M_TOK * 1024;
constexpr size_t OUT_PV = OUT_PK + 2 * 8 * 128 * 256;
constexpr size_t OUT_PG = OUT_PV + 2 * 8 * 128 * 256;
constexpr size_t OUT_PC = OUT_PG + (size_t)8 * 16 * 128 * 128;
constexpr size_t OUT_PH = OUT_PC + 8 * 3 * 4096;
constexpr size_t OUT_SK = OUT_PH + (size_t)8 * 8 * 128 * 128;
constexpr size_t OUT_SV = OUT_SK + (size_t)2 * 128 * 128 * 256;
constexpr size_t OUT_SG = OUT_SV + (size_t)2 * 128 * 128 * 256;
constexpr size_t OUT_SC = OUT_SG + (size_t)128 * 16 * 128 * 128;
constexpr size_t OUT_SH = OUT_SC + (size_t)128 * 3 * 4096;
constexpr size_t OUT_END = OUT_SH + (size_t)128 * 8 * 128 * 128;

constexpr size_t WT_FFN_IN = 0;
constexpr size_t WT_FFN_OUT = WT_FFN_IN + (size_t)8 * 5632 * 1024 * 2;
constexpr size_t WT_SWA_IN = WT_FFN_OUT + (size_t)8 * 1024 * 2816 * 2;
constexpr size_t WT_SWA_OUT = WT_SWA_IN + (size_t)2 * 1536 * 1024 * 2;
constexpr size_t WT_GDN_IN = WT_SWA_OUT + (size_t)2 * 1024 * 1024 * 2;
constexpr size_t WT_GDN_OUT = WT_GDN_IN + (size_t)6400 * 1024 * 2;
constexpr size_t WT_HG_IN = WT_GDN_OUT + (size_t)1024 * 2048 * 2;
constexpr size_t WT_HG_OUT = WT_HG_IN + (size_t)4096 * 1024 * 2;
constexpr size_t OFF_XG = WT_HG_OUT + (size_t)1024 * 1024 * 2;
constexpr size_t OFF_HID = OFF_XG + (size_t)M_TOK * 1024 * 2;
constexpr size_t OFF_PROJ = OFF_HID + (size_t)M_TOK * 2816 * 2;
constexpr size_t OFF_O = OFF_PROJ + (size_t)M_TOK * 6400 * 2;
constexpr size_t OFF_SS = OFF_O + (size_t)M_TOK * 2048 * 2;
constexpr size_t OFF_BA = OFF_SS + (size_t)2 * M_TOK * 16 * 4;
constexpr size_t OFF_ROPE = OFF_BA + (size_t)M_TOK * 32 * 4;
constexpr size_t OFF_LB = OFF_ROPE + (size_t)2052 * 16 * 4;
constexpr size_t OFF_GW = OFF_LB + 4096;
constexpr size_t OFF_GUT = OFF_GW + (size_t)4096 * 8192 * 2;
constexpr size_t WS_END = OFF_GUT + (size_t)4096 * 8192 * 2;
constexpr size_t OFF_QN = OFF_XG;
constexpr size_t OFF_KN = OFF_QN + (size_t)2048 * 8192 * 2;
constexpr size_t OFF_ATT = OFF_KN + (size_t)2048 * 8192 * 2;
constexpr size_t OFF_GCUM = OFF_ATT + (size_t)4096 * 4096 * 2;
static_assert(OFF_GCUM + 4096 * 64 * 4 <= OFF_PROJ, "alias overflow");
constexpr size_t OFF_FZ = OFF_PROJ + (size_t)M_TOK * 4096 * 2;
static_assert(OFF_FZ + (size_t)M_TOK * 1024 * 4 <= OFF_O, "fz overflow");

struct WD { const float* src; bf16_t* dst; int K, N, Nrows, mode, tile0, pad; };
constexpr int NWD = 24;

struct Params {
    const float *x_prompt, *x_sample, *cache_k, *cache_v, *state_gdn, *state_conv, *state_hgrn;
    const float *norm_ffn, *ffn_w_in, *ffn_w_out, *norm_mix, *swa_w_in, *swa_w_out, *swa_sinks;
    const float *gdn_w_in, *gdn_conv_w, *gdn_a_log, *gdn_dt_bias, *gdn_norm, *gdn_w_out;
    const float *hgrn_w_in, *hgrn_lb, *hgrn_norm, *hgrn_w_out, *final_norm;
    float* out; unsigned char* ws;
    float inv_freq[8];
    WD wd[NWD];
    int wd_total, nprog;
    unsigned char prog[48];
};

__device__ __forceinline__ int otid() { int t = threadIdx.x; asm volatile("" : "+v"(t)); return t; }
__device__ __forceinline__ int obid() { int b = blockIdx.x; asm volatile("" : "+s"(b)); return b; }

__device__ __forceinline__ float bf2f(bf16_t b) { return __uint_as_float(((unsigned)b) << 16); }
__device__ __forceinline__ float bflo(unsigned w) { return __uint_as_float(w << 16); }
__device__ __forceinline__ float bfhi(unsigned w) { return __uint_as_float(w & 0xffff0000u); }
__device__ __forceinline__ bf16_t f2bf(float f) { return (bf16_t)(cvt_pk_bf16(f, 0.f) & 0xffffu); }
__device__ __forceinline__ u32x2 pack4(f32x4 v) { u32x2 r; r.x = cvt_pk_bf16(v[0], v[1]); r.y = cvt_pk_bf16(v[2], v[3]); return r; }
__device__ __forceinline__ f32x4 unpack4(u32x2 w) { f32x4 r; r[0] = bflo(w.x); r[1] = bfhi(w.x); r[2] = bflo(w.y); r[3] = bfhi(w.y); return r; }
__device__ __forceinline__ float fast_exp(float x) { return __builtin_amdgcn_exp2f(x * 1.4426950408889634f); }
__device__ __forceinline__ float sigmoidf_(float x) { return __builtin_amdgcn_rcpf(1.0f + fast_exp(-x)); }
__device__ __forceinline__ float siluf_(float x) { return x * sigmoidf_(x); }
__device__ __forceinline__ float wave_sum(float v) {
#pragma unroll
    for (int o = 1; o < 64; o <<= 1) v += __shfl_xor(v, o);
    return v;
}
__device__ __forceinline__ float wave_max(float v) {
#pragma unroll
    for (int o = 1; o < 64; o <<= 1) v = fmaxf(v, __shfl_xor(v, o));
    return v;
}
__device__ __forceinline__ f32x4 mfma16(bf16x8 a, bf16x8 b, f32x4 c) { return __builtin_amdgcn_mfma_f32_16x16x32_bf16(a, b, c, 0, 0, 0); }
__device__ __forceinline__ bf16x8 cat8(u32x2 lo, u32x2 hi) { u32x4 w; w.x = lo.x; w.y = lo.y; w.z = hi.x; w.w = hi.y; return __builtin_bit_cast(bf16x8, w); }

__device__ __forceinline__ float row_rstd(const float* ss, int row) {
    const f32x4* sp = (const f32x4*)(ss + (size_t)row * 16);
    const f32x4 a = sp[0], b = sp[1], c = sp[2], d = sp[3];
    const f32x4 t = (a + b) + (c + d);
    return rsqrtf(((t[0] + t[1]) + (t[2] + t[3])) * (1.0f / 1024.0f) + EPS);
}
struct EpiSwiglu {
    static constexpr bool PERM = true, AFTER_DRAIN = false;
    bf16_t* H; const float* ss;
    __device__ __forceinline__ void operator()(const f32x4 (&acc)[2][2][4][2], const Unit& u, int wr, int wc, int fr, int fq) const {
        const int row0 = u.pm * 256 + wr * 64 + fr, col0 = u.pn * 128 + wc * 32 + 8 * fq;
#pragma unroll
        for (int ai = 0; ai < 2; ++ai)
#pragma unroll
            for (int m = 0; m < 4; ++m) {
                const int row = row0 + ai * 128 + m * 16;
                const float rs = row_rstd(ss, row);
                float h[8];
#pragma unroll
                for (int n = 0; n < 2; ++n)
#pragma unroll
                    for (int j = 0; j < 4; ++j) { const float g = acc[ai][0][m][n][j] * rs, up = acc[ai][1][m][n][j] * rs; h[n * 4 + j] = siluf_(g) * up; }
                u32x4 w; w.x = cvt_pk_bf16(h[0], h[1]); w.y = cvt_pk_bf16(h[2], h[3]); w.z = cvt_pk_bf16(h[4], h[5]); w.w = cvt_pk_bf16(h[6], h[7]);
                *(u32x4*)(H + (size_t)row * DFF + col0) = w;
            }
    }
};
struct EpiResid {
    static constexpr bool PERM = false, AFTER_DRAIN = false;
    float* X; bf16_t* XG; const float* g; float* ssn; float scale;
    __device__ __forceinline__ void operator()(const f32x4 (&acc)[2][2][4][2], const Unit& u, int wr, int wc, int fr, int fq) const {
        const int row0 = u.pm * 256 + wr * 64 + fr, col0 = u.pn * 256 + wc * 32 + 4 * fq;
        f32x4 gv[2][2];
#pragma unroll
        for (int bj = 0; bj < 2; ++bj)
#pragma unroll
            for (int n = 0; n < 2; ++n) gv[bj][n] = *(const f32x4*)(g + col0 + bj * 128 + n * 16);
#pragma unroll
        for (int ai = 0; ai < 2; ++ai)
#pragma unroll
            for (int m = 0; m < 4; ++m) {
                const int row = row0 + ai * 128 + m * 16;
                float* xr = X + (size_t)row * 1024 + col0; bf16_t* gr = XG + (size_t)row * 1024 + col0;
                float part = 0.f;
#pragma unroll
                for (int bj = 0; bj < 2; ++bj)
#pragma unroll
                    for (int n = 0; n < 2; ++n) {
                        const f32x4 xo = *(const f32x4*)(xr + bj * 128 + n * 16);
                        const f32x4 xn = xo + acc[ai][bj][m][n] * scale;
                        *(f32x4*)(xr + bj * 128 + n * 16) = xn;
                        part += (xn[0] * xn[0] + xn[1] * xn[1]) + (xn[2] * xn[2] + xn[3] * xn[3]);
                        *(u32x2*)(gr + bj * 128 + n * 16) = pack4(xn * gv[bj][n]);
                    }
                part += __shfl_xor(part, 16); part += __shfl_xor(part, 32);
                if (fq == 0) ssn[(size_t)row * 16 + u.pn * 4 + wc] = part;
            }
    }
};
struct EpiProj {
    static constexpr bool PERM = true, AFTER_DRAIN = false;
    bf16_t* P; int ld; const float* ss; int mode; const float* rope; float* side;
    __device__ __forceinline__ void operator()(const f32x4 (&acc)[2][2][4][2], const Unit& u, int wr, int wc, int fr, int fq) const {
        const int row0 = u.pm * 256 + wr * 64 + fr, colb = u.pn * 256 + wc * 32 + 8 * fq;
#pragma unroll
        for (int ai = 0; ai < 2; ++ai)
#pragma unroll
            for (int m = 0; m < 4; ++m) {
                const int row = row0 + ai * 128 + m * 16;
                const float rs = row_rstd(ss, row);
#pragma unroll
                for (int bj = 0; bj < 2; ++bj) {
                    const int col = colb + bj * 128;
                    f32x4 v0 = acc[ai][bj][m][0] * rs, v1 = acc[ai][bj][m][1] * rs;
                    if (mode == 0 && u.pn < 5 && (wc & 1) == 0) {
                        f32x4 p0, p1;
#pragma unroll
                        for (int j = 0; j < 4; ++j) { p0[j] = __shfl_xor(v0[j], 16); p1[j] = __shfl_xor(v1[j], 16); }
                        if (fq < 2) {
                            const int pidx = row < MP ? (row & 2047) : 2048 + ((row - MP) & 3);
                            const float* rp = rope + pidx * 16;
                            const f32x4 c0 = *(const f32x4*)rp, c1 = *(const f32x4*)(rp + 4), s0 = *(const f32x4*)(rp + 8), s1 = *(const f32x4*)(rp + 12);
                            const float sg = fq == 0 ? -1.f : 1.f;
                            v0 = v0 * c0 + p0 * s0 * sg; v1 = v1 * c1 + p1 * s1 * sg;
                        }
                    }
                    u32x4 w; w.x = cvt_pk_bf16(v0[0], v0[1]); w.y = cvt_pk_bf16(v0[2], v0[3]); w.z = cvt_pk_bf16(v1[0], v1[1]); w.w = cvt_pk_bf16(v1[2], v1[3]);
                    *(u32x4*)(P + (size_t)row * ld + col) = w;
                    if (mode == 1 && u.pn == 24 && bj == 0 && wc == 0) { float* sp = side + (size_t)row * 32 + 8 * fq; *(f32x4*)sp = v0; *(f32x4*)(sp + 4) = v1; }
                    if (mode == 2 && u.pn >= 4 && u.pn < 8) { float* sp = side + (size_t)row * 1024 + (col - 1024); *(f32x4*)sp = v0; *(f32x4*)(sp + 4) = v1; }
                }
            }
    }
};

__device__ __forceinline__ void ph_prologue(const Params& p, unsigned char* shm) {
    const int tid = otid(), lane = tid & 63, wave = tid >> 6;
    const int gt = obid() * 512 + tid, ngt = gridDim.x * 512;
    float* SS = (float*)(p.ws + OFF_SS);
    float* rope = (float*)(p.ws + OFF_ROPE);
    for (int i = gt; i < 2052 * 8; i += ngt) {
        const int pidx = i >> 3, k = i & 7; const int pos = pidx < 2048 ? pidx : 8192 + (pidx - 2048);
        const double ang = (double)pos * (double)p.inv_freq[k];
        double rev = ang * 0.15915494309189535; rev -= __builtin_rint(rev);
        const float a = (float)(rev * 6.283185307179586);
        rope[pidx * 16 + k] = __cosf(a); rope[pidx * 16 + 8 + k] = __sinf(a);
    }
    float* LB = (float*)(p.ws + OFF_LB);
    for (int i = gt; i < 1024; i += ngt) {
        const float l0 = p.hgrn_lb[i], l1 = p.hgrn_lb[1024 + i], l2 = p.hgrn_lb[2048 + i], l3 = p.hgrn_lb[3072 + i];
        const float mx = fmaxf(fmaxf(l0, l1), fmaxf(l2, l3));
        const float e0 = expf(l0 - mx), e1 = expf(l1 - mx), e2 = expf(l2 - mx), e3 = expf(l3 - mx);
        LB[i] = (e1 + e2) / (e0 + e1 + e2 + e3);
    }
    float* X = p.out; bf16_t* XG = (bf16_t*)(p.ws + OFF_XG);
    for (int r = obid() * 8 + wave; r < M_TOK; r += gridDim.x * 8) {
        const float* src = r < MP ? p.x_prompt + (size_t)r * 1024 : p.x_sample + (size_t)(r - MP) * 1024;
        float s = 0.f;
#pragma unroll
        for (int j = 0; j < 4; ++j) {
            const int c = lane * 4 + 256 * j;
            const f32x4 v = *(const f32x4*)(src + c), g = *(const f32x4*)(p.norm_ffn + c);
            *(f32x4*)(X + (size_t)r * 1024 + c) = v;
            s += (v[0] * v[0] + v[1] * v[1]) + (v[2] * v[2] + v[3] * v[3]);
            *(u32x2*)(XG + (size_t)r * 1024 + c) = pack4(v * g);
        }
        s = wave_sum(s);
        if (lane < 16) SS[(size_t)r * 16 + lane] = lane == 0 ? s : 0.f;
    }
    float* tile = (float*)shm;
    for (int it = obid(); it < p.wd_total; it += gridDim.x) {
        int d = 0;
#pragma unroll 1
        while (d + 1 < NWD && it >= p.wd[d + 1].tile0) ++d;
        const float* src = p.wd[d].src; bf16_t* dst = p.wd[d].dst; const int K = p.wd[d].K, N = p.wd[d].N, mode = p.wd[d].mode, ntn = p.wd[d].Nrows >> 6;
        const int t = it - p.wd[d].tile0, k0 = (t / ntn) * 128, n0 = (t % ntn) * 64;
        {
            const int c = tid & 63, kr = tid >> 6; const int np = n0 + c; int col; bool ok = true;
            if (mode == 1) { const int pn = np >> 8, w = np & 255; col = (w >> 7) * DFF + pn * 128 + (w & 127); } else { col = np; ok = np < N; }
#pragma unroll
            for (int i = 0; i < 16; ++i) { const int k = kr + 8 * i; tile[k * 65 + c] = ok ? src[(size_t)(k0 + k) * N + col] : 0.f; }
        }
        __syncthreads();
#pragma unroll
        for (int i = 0; i < 2; ++i) {
            const int e = tid + 512 * i, nr = e >> 4, ch = e & 15;
            const float* s = tile + (ch * 8) * 65 + nr;
            u32x4 o; o.x = cvt_pk_bf16(s[0], s[65]); o.y = cvt_pk_bf16(s[2 * 65], s[3 * 65]); o.z = cvt_pk_bf16(s[4 * 65], s[5 * 65]); o.w = cvt_pk_bf16(s[6 * 65], s[7 * 65]);
            *(u32x4*)(dst + (size_t)(n0 + nr) * K + k0 + ch * 8) = o;
        }
        __syncthreads();
    }
}

__device__ __forceinline__ void ph_final(const Params& p) {
    const int lane = otid() & 63, wave = otid() >> 6;
    const float* ss = (const float*)(p.ws + OFF_SS);
    for (int r = obid() * 8 + wave; r < M_TOK; r += gridDim.x * 8) {
        const float rs = row_rstd(ss, r);
#pragma unroll
        for (int j = 0; j < 4; ++j) {
            const int c = lane * 4 + 256 * j;
            float* xp = p.out + (size_t)r * 1024 + c;
            *(f32x4*)xp = *(const f32x4*)xp * rs * *(const f32x4*)(p.final_norm + c);
        }
    }
}

__device__ __forceinline__ void swa_prompt_item(const Params& p, unsigned char* shm, int j, int item) {
    const int tid = otid(), lane = tid & 63, wave = tid >> 6, fr = lane & 15, fq = lane >> 4;
    const int n = item & 15, kvh = (item >> 4) & 3, b = item >> 6;
    const bf16_t* P = (const bf16_t*)(p.ws + OFF_PROJ);
    bf16_t* Ob = (bf16_t*)(p.ws + OFF_O);
    bf16_t* Ks = (bf16_t*)shm;
    bf16_t* Vt = (bf16_t*)(shm + 36864);
    const size_t rowbase = (size_t)b * 2048;
    for (int e = tid; e < 2048; e += 512) {
        const int key = e >> 3, ch = e & 7; const int pos = (n - 1) * 128 + key;
        u32x4 kv = {0u, 0u, 0u, 0u}, vv = {0u, 0u, 0u, 0u};
        if (pos >= 0) { const bf16_t* src = P + (rowbase + pos) * 1536; kv = *(const u32x4*)(src + 1024 + kvh * 64 + ch * 8); vv = *(const u32x4*)(src + 1280 + kvh * 64 + ch * 8); }
        *(u32x4*)(Ks + key * 72 + ch * 8) = kv;
#pragma unroll
        for (int q = 0; q < 4; ++q) { Vt[(ch * 8 + 2 * q) * 264 + key] = (bf16_t)(vv[q] & 0xffffu); Vt[(ch * 8 + 2 * q + 1) * 264 + key] = (bf16_t)(vv[q] >> 16); }
        if (n == 15 && key >= 128) {
            const size_t o = ((size_t)((j * 8 + b) * 128 + (key - 128))) * 256 + kvh * 64 + ch * 8;
            float* ok = p.out + OUT_PK + o; float* ov = p.out + OUT_PV + o;
#pragma unroll
            for (int q = 0; q < 4; ++q) { ok[2 * q] = bflo(kv[q]); ok[2 * q + 1] = bfhi(kv[q]); ov[2 * q] = bflo(vv[q]); ov[2 * q + 1] = bfhi(vv[q]); }
        }
    }
    __syncthreads();
    const int g = wave >> 1, qh = wave & 1, h = kvh * 4 + g;
    const float sink = p.swa_sinks[j * 16 + h];
#pragma unroll 1
    for (int ti = 0; ti < 4; ++ti) {
        const int q0 = qh * 64 + ti * 16, T0 = q0 >> 4;
        const bf16_t* qsrc = P + (rowbase + n * 128 + q0 + fr) * 1536 + h * 64 + fq * 8;
        const bf16x8 qf0 = *(const bf16x8*)qsrc, qf1 = *(const bf16x8*)(qsrc + 32);
        f32x4 s[9];
#pragma unroll
        for (int kt = 0; kt < 9; ++kt) {
            const bf16_t* kp = Ks + ((T0 + kt) * 16 + fr) * 72 + fq * 8;
            f32x4 a = {0.f, 0.f, 0.f, 0.f};
            a = mfma16(*(const bf16x8*)kp, qf0, a); a = mfma16(*(const bf16x8*)(kp + 32), qf1, a);
            s[kt] = a;
        }
        const int ql = q0 + fr; float mx = -1e30f;
#pragma unroll
        for (int kt = 0; kt < 9; ++kt)
#pragma unroll
            for (int jj = 0; jj < 4; ++jj) {
                const int kl = (T0 + kt) * 16 + 4 * fq + jj;
                const bool valid = (kl > ql) && (kl <= ql + 128) && (n > 0 || kl >= 128);
                const float v = valid ? s[kt][jj] * 0.125f : -1e30f; s[kt][jj] = v; mx = fmaxf(mx, v);
            }
        mx = fmaxf(mx, __shfl_xor(mx, 16)); mx = fmaxf(mx, __shfl_xor(mx, 32)); mx = fmaxf(mx, sink);
        float l = 0.f;
#pragma unroll
        for (int kt = 0; kt < 9; ++kt)
#pragma unroll
            for (int jj = 0; jj < 4; ++jj) { const float e = fast_exp(s[kt][jj] - mx); s[kt][jj] = e; l += e; }
        l += __shfl_xor(l, 16); l += __shfl_xor(l, 32); l += fast_exp(sink - mx);
        bf16x8 pf[5];
#pragma unroll
        for (int u = 0; u < 4; ++u) pf[u] = cat8(pack4(s[2 * u]), pack4(s[2 * u + 1]));
        { const u32x2 z = {0u, 0u}; pf[4] = cat8(pack4(s[8]), z); }
        f32x4 o[4];
#pragma unroll
        for (int td = 0; td < 4; ++td) {
            f32x4 a = {0.f, 0.f, 0.f, 0.f};
#pragma unroll
            for (int u = 0; u < 5; ++u) {
                const bf16_t* vp = Vt + (td * 16 + fr) * 264 + (T0 + 2 * u) * 16 + 4 * fq;
                const u32x2 lo = *(const u32x2*)vp; u32x2 hi = {0u, 0u};
                if (u < 4) hi = *(const u32x2*)(vp + 16);
                a = mfma16(cat8(lo, hi), pf[u], a);
            }
            o[td] = a;
        }
        const float inv = 1.0f / l;
        bf16_t* op = Ob + (rowbase + n * 128 + q0 + fr) * 1024 + h * 64 + 4 * fq;
#pragma unroll
        for (int td = 0; td < 4; ++td) *(u32x2*)(op + td * 16) = pack4(o[td] * inv);
    }
    __syncthreads();
}

__device__ __forceinline__ void swa_sample_item(const Params& p, unsigned char* shm, int j, int item) {
    const int tid = otid(), lane = tid & 63, wave = tid >> 6;
    const int kvh = item & 3, b = item >> 2;
    const bf16_t* P = (const bf16_t*)(p.ws + OFF_PROJ);
    bf16_t* Ob = (bf16_t*)(p.ws + OFF_O);
    float* Kc = (float*)shm;
    float* Vc = Kc + 132 * 65;
    float* Qs = Vc + 132 * 64;
    float* Ss = Qs + 16 * 64;
    const size_t cb = ((size_t)(j * 128 + b) * 128) * 256 + kvh * 64;
    const float* ck = p.cache_k + cb; const float* cv = p.cache_v + cb;
    float* ok = p.out + OUT_SK + cb; float* ov = p.out + OUT_SV + cb;
    for (int e = tid; e < 132 * 64; e += 512) {
        const int row = e >> 6, d = e & 63; float kx, vx;
        if (row < 128) { kx = ck[row * 256 + d]; vx = cv[row * 256 + d]; }
        else { const bf16_t* src = P + (size_t)(MP + b * 4 + row - 128) * 1536; kx = bf2f(src[1024 + kvh * 64 + d]); vx = bf2f(src[1280 + kvh * 64 + d]); }
        Kc[row * 65 + d] = kx; Vc[row * 64 + d] = vx;
        if (row >= 4) { ok[(row - 4) * 256 + d] = kx; ov[(row - 4) * 256 + d] = vx; }
    }
    for (int e = tid; e < 1024; e += 512) { const int r = e >> 6, d = e & 63, g = r >> 2, t = r & 3; Qs[e] = bf2f(P[(size_t)(MP + b * 4 + t) * 1536 + (kvh * 4 + g) * 64 + d]); }
    __syncthreads();
    for (int e = tid; e < 16 * 132; e += 512) {
        const int r = e / 132, key = e - r * 132, t = r & 3; float acc = 0.f;
#pragma unroll 16
        for (int d = 0; d < 64; ++d) acc += Qs[r * 64 + d] * Kc[key * 65 + d];
        const bool valid = key >= t + 1 && key <= t + 128;
        Ss[r * 136 + key] = valid ? acc * 0.125f : -1e30f;
    }
    __syncthreads();
#pragma unroll
    for (int rr = 0; rr < 2; ++rr) {
        const int r = 2 * wave + rr, g = r >> 2; const float sink = p.swa_sinks[j * 16 + kvh * 4 + g];
        const float v0 = Ss[r * 136 + lane], v1 = Ss[r * 136 + 64 + lane], v2 = lane < 4 ? Ss[r * 136 + 128 + lane] : -1e30f;
        float mx = wave_max(fmaxf(fmaxf(v0, v1), v2)); mx = fmaxf(mx, sink);
        const float e0 = fast_exp(v0 - mx), e1 = fast_exp(v1 - mx), e2 = fast_exp(v2 - mx);
        const float l = wave_sum(e0 + e1 + e2) + fast_exp(sink - mx); const float inv = 1.0f / l;
        Ss[r * 136 + lane] = e0 * inv; Ss[r * 136 + 64 + lane] = e1 * inv; if (lane < 4) Ss[r * 136 + 128 + lane] = e2 * inv;
    }
    __syncthreads();
    for (int e = tid; e < 1024; e += 512) {
        const int r = e >> 6, d = e & 63, g = r >> 2, t = r & 3; float acc = 0.f;
#pragma unroll 4
        for (int key = 0; key < 132; ++key) acc += Ss[r * 136 + key] * Vc[key * 64 + d];
        Ob[(size_t)(MP + b * 4 + t) * 1024 + (kvh * 4 + g) * 64 + d] = f2bf(acc);
    }
    __syncthreads();
}

__device__ __forceinline__ void gdn_g1_unit(const Params& p, unsigned char* shm, int unit) {
    const int tid = otid(), lane = tid & 63, wave = tid >> 6, fr = lane & 15, fq = lane >> 4;
    const int c = unit & 31, vh = (unit >> 5) & 15, b = unit >> 9, hq = vh >> 1;
    const int R0 = b * 2048 + c * 64;
    const bf16_t* P = (const bf16_t*)(p.ws + OFF_PROJ);
    const float* BA = (const float*)(p.ws + OFF_BA);
    bf16_t* qn = (bf16_t*)shm;
    bf16_t* kn = qn + 64 * 136;
    bf16_t* kbgT = kn + 64 * 136;
    bf16_t* vbT = kbgT + 128 * 72;
    float* Af = (float*)(vbT + 128 * 72);
    bf16_t* Tb = (bf16_t*)(Af + 64 * 68);
    float* gc = (float*)(Tb + 64 * 72);
    float* bt = gc + 64;
    float* GCUM = (float*)(p.ws + OFF_GCUM);
    if (wave == 0) {
        const int r = R0 + lane;
        const float a = BA[(size_t)r * 32 + 16 + vh] + p.gdn_dt_bias[vh];
        const float sp = a > 20.f ? a : log1pf(expf(a));
        const float g = -expf(p.gdn_a_log[vh]) * sp;
        const float be = 1.0f / (1.0f + expf(-BA[(size_t)r * 32 + vh]));
        float cs = g;
#pragma unroll
        for (int o = 1; o < 64; o <<= 1) { const float t = __shfl_up(cs, o); if (lane >= o) cs += t; }
        gc[lane] = cs; bt[lane] = be; GCUM[(size_t)unit * 64 + lane] = cs;
    }
    __syncthreads();
    {
        const int i = tid >> 3, cb = tid & 7, t = c * 64 + i;
        const float be = bt[i], eg = expf(gc[i]);
        const int uq = (b * 8 + hq) * 32 + c;
#pragma unroll
        for (int op = 0; op < 3; ++op) {
            const int col = op == 0 ? hq * 128 + cb * 16 : (op == 1 ? 1024 + hq * 128 + cb * 16 : 2048 + vh * 128 + cb * 16);
            float acc[16];
#pragma unroll
            for (int e = 0; e < 16; ++e) acc[e] = 0.f;
#pragma unroll
            for (int jj = 0; jj < 4; ++jj) {
                const int tt = t - 3 + jj;
                if (tt >= 0) {
                    const bf16_t* src = P + (size_t)(b * 2048 + tt) * 6400 + col;
                    const u32x4 xa = *(const u32x4*)src, xb = *(const u32x4*)(src + 8);
                    const float* w = p.gdn_conv_w + jj * 4096 + col;
                    float x[16];
#pragma unroll
                    for (int q = 0; q < 4; ++q) { x[2 * q] = bflo(xa[q]); x[2 * q + 1] = bfhi(xa[q]); x[8 + 2 * q] = bflo(xb[q]); x[8 + 2 * q + 1] = bfhi(xb[q]); }
#pragma unroll
                    for (int q = 0; q < 4; ++q) { const f32x4 wv = *(const f32x4*)(w + 4 * q);
#pragma unroll
                        for (int e = 0; e < 4; ++e) acc[4 * q + e] += x[4 * q + e] * wv[e]; }
                    if (jj == 3 && c == 31 && i >= 61 && (op == 2 || (vh & 1) == 0)) {
                        float* pc = p.out + OUT_PC + (size_t)(b * 3 + (i - 61)) * 4096 + col;
#pragma unroll
                        for (int q = 0; q < 4; ++q) { f32x4 o; o[0] = x[4 * q]; o[1] = x[4 * q + 1]; o[2] = x[4 * q + 2]; o[3] = x[4 * q + 3]; *(f32x4*)(pc + 4 * q) = o; }
                    }
                }
            }
#pragma unroll
            for (int e = 0; e < 16; ++e) acc[e] = siluf_(acc[e]);
            if (op < 2) {
                float ss = 0.f;
#pragma unroll
                for (int e = 0; e < 16; ++e) ss += acc[e] * acc[e];
                ss += __shfl_xor(ss, 1); ss += __shfl_xor(ss, 2); ss += __shfl_xor(ss, 4);
                float rn = rsqrtf(ss + 1e-6f); if (op == 0) rn *= 0.08838834764831845f;
#pragma unroll
                for (int e = 0; e < 16; ++e) acc[e] *= rn;
                u32x4 w0, w1;
#pragma unroll
                for (int q = 0; q < 4; ++q) { w0[q] = cvt_pk_bf16(acc[2 * q], acc[2 * q + 1]); w1[q] = cvt_pk_bf16(acc[8 + 2 * q], acc[8 + 2 * q + 1]); }
                bf16_t* ld = (op == 0 ? qn : kn) + i * 136 + cb * 16;
                *(u32x4*)ld = w0; *(u32x4*)(ld + 8) = w1;
                if ((vh & 1) == 0) {
                    bf16_t* gd = (bf16_t*)(p.ws + (op == 0 ? OFF_QN : OFF_KN)) + (size_t)uq * 8192 + i * 128 + cb * 16;
                    *(u32x4*)gd = w0; *(u32x4*)(gd + 8) = w1;
                }
                if (op == 1) {
                    const float f = be * eg;
#pragma unroll
                    for (int e = 0; e < 16; ++e) kbgT[(cb * 16 + e) * 72 + i] = f2bf(acc[e] * f);
                }
            } else {
#pragma unroll
                for (int e = 0; e < 16; ++e) vbT[(cb * 16 + e) * 72 + i] = f2bf(acc[e] * be);
            }
        }
    }
    __syncthreads();
    {
        const int which = wave >> 2, ti = wave & 3; const bf16_t* bsrc = which ? qn : kn;
        bf16x8 bfr[4];
#pragma unroll
        for (int ks = 0; ks < 4; ++ks) bfr[ks] = *(const bf16x8*)(bsrc + (ti * 16 + fr) * 136 + ks * 32 + fq * 8);
        const int i = ti * 16 + fr; const float gi = gc[i], bi = bt[i];
        bf16_t* ATT = (bf16_t*)(p.ws + OFF_ATT) + (size_t)unit * 4096;
#pragma unroll
        for (int tj = 0; tj < 4; ++tj) {
            f32x4 a = {0.f, 0.f, 0.f, 0.f};
            if (tj <= ti) {
#pragma unroll
                for (int ks = 0; ks < 4; ++ks) a = mfma16(*(const bf16x8*)(kn + (tj * 16 + fr) * 136 + ks * 32 + fq * 8), bfr[ks], a);
            }
            f32x4 r;
#pragma unroll
            for (int jj = 0; jj < 4; ++jj) {
                const int jx = tj * 16 + 4 * fq + jj;
                const float dec = expf(fminf(gi - gc[jx], 0.f));
                r[jj] = which ? (jx <= i ? a[jj] * dec : 0.f) : (jx < i ? a[jj] * dec * bi : 0.f);
            }
            if (which == 0) *(f32x4*)(Af + i * 68 + tj * 16 + 4 * fq) = r;
            else *(u32x2*)(ATT + i * 64 + tj * 16 + 4 * fq) = pack4(r);
        }
    }
    __syncthreads();
    if (wave == 0) {
        int vz; asm volatile("v_mov_b32 %0, 0" : "=v"(vz));
        const float* Afv = Af + vz;
        float t[64];
#pragma unroll
        for (int i = 0; i < 64; ++i) t[i] = 0.f;
#pragma unroll
        for (int i = 0; i < 64; ++i) {
            float acc = (i == lane) ? 1.f : 0.f;
#pragma unroll
            for (int j4 = 0; j4 < i; j4 += 4) {
                const f32x4 a = *(const f32x4*)(Afv + i * 68 + j4);
                acc -= a[0] * t[j4]; acc -= a[1] * t[j4 + 1]; acc -= a[2] * t[j4 + 2]; acc -= a[3] * t[j4 + 3];
            }
            t[i] = acc;
        }
#pragma unroll
        for (int i = 0; i < 64; ++i) Tb[i * 72 + lane] = f2bf(t[i]);
    }
    __syncthreads();
    {
        const int td = wave;
        const bf16x8 a0 = *(const bf16x8*)(kbgT + (td * 16 + fr) * 72 + fq * 8), a1 = *(const bf16x8*)(kbgT + (td * 16 + fr) * 72 + 32 + fq * 8);
        const bf16x8 v0 = *(const bf16x8*)(vbT + (td * 16 + fr) * 72 + fq * 8), v1 = *(const bf16x8*)(vbT + (td * 16 + fr) * 72 + 32 + fq * 8);
        bf16_t* W = (bf16_t*)(p.ws + OFF_GW) + (size_t)unit * 8192; bf16_t* UT = (bf16_t*)(p.ws + OFF_GUT) + (size_t)unit * 8192;
#pragma unroll
        for (int ti = 0; ti < 4; ++ti) {
            const bf16x8 t0 = *(const bf16x8*)(Tb + (ti * 16 + fr) * 72 + fq * 8), t1 = *(const bf16x8*)(Tb + (ti * 16 + fr) * 72 + 32 + fq * 8);
            f32x4 w = {0.f, 0.f, 0.f, 0.f}; w = mfma16(a0, t0, w); w = mfma16(a1, t1, w);
            *(u32x2*)(W + (ti * 16 + fr) * 128 + td * 16 + 4 * fq) = pack4(w);
            f32x4 uu = {0.f, 0.f, 0.f, 0.f}; uu = mfma16(t0, v0, uu); uu = mfma16(t1, v1, uu);
            *(u32x2*)(UT + (td * 16 + fr) * 64 + ti * 16 + 4 * fq) = pack4(uu);
        }
    }
    __syncthreads();
}

__device__ __forceinline__ void gdn_g2_seq(const Params& p, unsigned char* shm, int seq) {
    const int tid = otid(), lane = tid & 63, wave = tid >> 6, fr = lane & 15, fq = lane >> 4;
    const int vh = seq & 15, b = seq >> 4, hq = vh >> 1;
    bf16_t* wS = (bf16_t*)shm;
    bf16_t* qg = wS + 64 * 136;
    bf16_t* kdT = qg + 64 * 136;
    bf16_t* att = kdT + 128 * 72;
    bf16_t* vnT = att + 64 * 72;
    bf16_t* St = vnT + 128 * 72;
    float* red = (float*)(St + 128 * 136);
    const bf16_t* P = (const bf16_t*)(p.ws + OFF_PROJ);
    bf16_t* Ob = (bf16_t*)(p.ws + OFF_O);
    const float* GCUM = (const float*)(p.ws + OFF_GCUM);
    f32x4 S[8];
#pragma unroll
    for (int tk = 0; tk < 8; ++tk) { S[tk] = (f32x4){0.f, 0.f, 0.f, 0.f}; *(u32x2*)(St + (wave * 16 + fr) * 136 + tk * 16 + 4 * fq) = (u32x2){0u, 0u}; }
    const f32x4 ng = *(const f32x4*)(p.gdn_norm + wave * 16 + 4 * fq);
#pragma unroll 1
    for (int c = 0; c < 32; ++c) {
        const int unit = seq * 32 + c, uq = (b * 8 + hq) * 32 + c;
        const float glast = GCUM[(size_t)unit * 64 + 63];
        __syncthreads();
        {
            const bf16_t* W = (const bf16_t*)(p.ws + OFF_GW) + (size_t)unit * 8192;
            const bf16_t* QN = (const bf16_t*)(p.ws + OFF_QN) + (size_t)uq * 8192;
            const bf16_t* KN = (const bf16_t*)(p.ws + OFF_KN) + (size_t)uq * 8192;
#pragma unroll
            for (int it = 0; it < 2; ++it) {
                const int e = tid + 512 * it, i = e >> 4, ch = e & 15;
                *(u32x4*)(wS + i * 136 + ch * 8) = *(const u32x4*)(W + i * 128 + ch * 8);
                const float gi = GCUM[(size_t)unit * 64 + i]; const float eq = expf(gi), ek = expf(glast - gi);
                const u32x4 qv = *(const u32x4*)(QN + i * 128 + ch * 8), kv = *(const u32x4*)(KN + i * 128 + ch * 8);
                u32x4 qo;
#pragma unroll
                for (int q = 0; q < 4; ++q) {
                    qo[q] = cvt_pk_bf16(bflo(qv[q]) * eq, bfhi(qv[q]) * eq);
                    kdT[(ch * 8 + 2 * q) * 72 + i] = f2bf(bflo(kv[q]) * ek); kdT[(ch * 8 + 2 * q + 1) * 72 + i] = f2bf(bfhi(kv[q]) * ek);
                }
                *(u32x4*)(qg + i * 136 + ch * 8) = qo;
            }
            { const int i = tid >> 3, ch = tid & 7; *(u32x4*)(att + i * 72 + ch * 8) = *(const u32x4*)((const bf16_t*)(p.ws + OFF_ATT) + (size_t)unit * 4096 + i * 64 + ch * 8); }
        }
        __syncthreads();
        bf16x8 sf[4];
#pragma unroll
        for (int ks = 0; ks < 4; ++ks) sf[ks] = *(const bf16x8*)(St + (wave * 16 + fr) * 136 + ks * 32 + fq * 8);
        {
            const bf16_t* UT = (const bf16_t*)(p.ws + OFF_GUT) + (size_t)unit * 8192;
#pragma unroll
            for (int ti = 0; ti < 4; ++ti) {
                f32x4 a = {0.f, 0.f, 0.f, 0.f};
#pragma unroll
                for (int ks = 0; ks < 4; ++ks) a = mfma16(*(const bf16x8*)(wS + (ti * 16 + fr) * 136 + ks * 32 + fq * 8), sf[ks], a);
                const f32x4 uu = unpack4(*(const u32x2*)(UT + (wave * 16 + fr) * 64 + ti * 16 + 4 * fq));
                *(u32x2*)(vnT + (wave * 16 + fr) * 72 + ti * 16 + 4 * fq) = pack4(uu - a);
            }
        }
        __syncthreads();
        bf16x8 vf[2];
#pragma unroll
        for (int ks = 0; ks < 2; ++ks) vf[ks] = *(const bf16x8*)(vnT + (wave * 16 + fr) * 72 + ks * 32 + fq * 8);
        f32x4 o[4];
#pragma unroll
        for (int ti = 0; ti < 4; ++ti) {
            f32x4 a = {0.f, 0.f, 0.f, 0.f};
#pragma unroll
            for (int ks = 0; ks < 4; ++ks) a = mfma16(sf[ks], *(const bf16x8*)(qg + (ti * 16 + fr) * 136 + ks * 32 + fq * 8), a);
#pragma unroll
            for (int ks = 0; ks < 2; ++ks) a = mfma16(vf[ks], *(const bf16x8*)(att + (ti * 16 + fr) * 72 + ks * 32 + fq * 8), a);
            o[ti] = a;
            float s2 = (a[0] * a[0] + a[1] * a[1]) + (a[2] * a[2] + a[3] * a[3]);
            s2 += __shfl_xor(s2, 16); s2 += __shfl_xor(s2, 32);
            if (fq == 0) red[wave * 64 + ti * 16 + fr] = s2;
        }
        __syncthreads();
#pragma unroll
        for (int ti = 0; ti < 4; ++ti) {
            const int i = ti * 16 + fr; float tot = 0.f;
#pragma unroll
            for (int w = 0; w < 8; ++w) tot += red[w * 64 + i];
            const float rn = rsqrtf(tot * (1.0f / 128.0f) + EPS);
            const size_t row = (size_t)b * 2048 + c * 64 + i;
            const f32x4 z = unpack4(*(const u32x2*)(P + row * 6400 + 4096 + vh * 128 + wave * 16 + 4 * fq));
            f32x4 r;
#pragma unroll
            for (int jj = 0; jj < 4; ++jj) r[jj] = o[ti][jj] * rn * ng[jj] * siluf_(z[jj]);
            *(u32x2*)(Ob + row * 2048 + vh * 128 + wave * 16 + 4 * fq) = pack4(r);
        }
        {
            const float eg = expf(glast);
#pragma unroll
            for (int tk = 0; tk < 8; ++tk) {
                f32x4 a = S[tk] * eg;
#pragma unroll
                for (int ks = 0; ks < 2; ++ks) a = mfma16(*(const bf16x8*)(kdT + (tk * 16 + fr) * 72 + ks * 32 + fq * 8), vf[ks], a);
                S[tk] = a;
                *(u32x2*)(St + (wave * 16 + fr) * 136 + tk * 16 + 4 * fq) = pack4(a);
            }
        }
    }
    float* pg = p.out + OUT_PG + (size_t)(b * 16 + vh) * 16384;
#pragma unroll
    for (int tk = 0; tk < 8; ++tk)
#pragma unroll
        for (int jj = 0; jj < 4; ++jj) pg[(tk * 16 + 4 * fq + jj) * 128 + wave * 16 + fr] = S[tk][jj];
    __syncthreads();
}

__device__ __forceinline__ void gdn_sample_item(const Params& p, unsigned char* shm, int item) {
    const int tid = otid(), lane = tid & 63, wave = tid >> 6;
    const int vh = item & 15, b = item >> 4, hq = vh >> 1;
    const bf16_t* P = (const bf16_t*)(p.ws + OFF_PROJ);
    const float* BA = (const float*)(p.ws + OFF_BA);
    bf16_t* Ob = (bf16_t*)(p.ws + OFF_O);
    float* qs = (float*)shm; float* ks = qs + 512; float* vs = ks + 512; float* red = vs + 512; float* sc = red + 512; float* part = sc + 16;
    const int t = tid >> 7, col = tid & 127;
    __syncthreads();
#pragma unroll
    for (int op = 0; op < 3; ++op) {
        const int cc = op == 0 ? hq * 128 + col : (op == 1 ? 1024 + hq * 128 + col : 2048 + vh * 128 + col);
        float acc = 0.f, xlast = 0.f;
#pragma unroll
        for (int jj = 0; jj < 4; ++jj) {
            const int xi = t + jj;
            const float x = xi < 3 ? p.state_conv[(size_t)(b * 3 + xi) * 4096 + cc] : bf2f(P[(size_t)(MP + b * 4 + xi - 3) * 6400 + cc]);
            acc += x * p.gdn_conv_w[jj * 4096 + cc]; xlast = x;
        }
        if (t >= 1 && (op == 2 || (vh & 1) == 0)) p.out[OUT_SC + (size_t)(b * 3 + t - 1) * 4096 + cc] = xlast;
        acc = siluf_(acc);
        (op == 0 ? qs : (op == 1 ? ks : vs))[tid] = acc;
    }
    if (tid < 4) {
        const size_t r = MP + b * 4 + tid;
        const float a = BA[r * 32 + 16 + vh] + p.gdn_dt_bias[vh];
        const float sp = a > 20.f ? a : log1pf(expf(a));
        sc[tid] = -expf(p.gdn_a_log[vh]) * sp; sc[4 + tid] = 1.0f / (1.0f + expf(-BA[r * 32 + vh]));
    }
    __syncthreads();
    {
        const float q = qs[tid], k = ks[tid];
        const float sq = wave_sum(q * q), sk = wave_sum(k * k);
        if (lane == 0) { part[wave] = sq; part[8 + wave] = sk; }
        __syncthreads();
        const float tq = part[2 * t] + part[2 * t + 1], tk = part[8 + 2 * t] + part[8 + 2 * t + 1];
        qs[tid] = q * rsqrtf(tq + 1e-6f) * 0.08838834764831845f; ks[tid] = k * rsqrtf(tk + 1e-6f);
    }
    __syncthreads();
    const int dv = tid & 127, grp = tid >> 7;
    float s[32];
    const float* sp = p.state_gdn + (size_t)(b * 16 + vh) * 16384;
#pragma unroll
    for (int e = 0; e < 32; ++e) s[e] = sp[(grp * 32 + e) * 128 + dv];
#pragma unroll 1
    for (int tt = 0; tt < 4; ++tt) {
        const float eg = expf(sc[tt]), be = sc[4 + tt];
        float r = 0.f;
#pragma unroll
        for (int e = 0; e < 32; ++e) { s[e] *= eg; r += s[e] * ks[tt * 128 + grp * 32 + e]; }
        red[grp * 128 + dv] = r;
        __syncthreads();
        const float rt = (red[dv] + red[128 + dv]) + (red[256 + dv] + red[384 + dv]);
        const float delta = be * (vs[tt * 128 + dv] - rt);
        float o = 0.f;
#pragma unroll
        for (int e = 0; e < 32; ++e) { s[e] += ks[tt * 128 + grp * 32 + e] * delta; o += s[e] * qs[tt * 128 + grp * 32 + e]; }
        __syncthreads();
        red[grp * 128 + dv] = o;
        __syncthreads();
        const float ot = (red[dv] + red[128 + dv]) + (red[256 + dv] + red[384 + dv]);
        const float so = wave_sum(ot * ot);
        if (lane == 0) part[wave] = so;
        __syncthreads();
        const float rn = rsqrtf((part[2 * grp] + part[2 * grp + 1]) * (1.0f / 128.0f) + EPS);
        if (grp == 0) {
            const size_t row = MP + b * 4 + tt;
            const float z = bf2f(P[row * 6400 + 4096 + vh * 128 + dv]);
            Ob[row * 2048 + vh * 128 + dv] = f2bf(ot * rn * p.gdn_norm[dv] * siluf_(z));
        }
        __syncthreads();
    }
    float* sg = p.out + OUT_SG + (size_t)(b * 16 + vh) * 16384;
#pragma unroll
    for (int e = 0; e < 32; ++e) sg[(grp * 32 + e) * 128 + dv] = s[e];
}

__device__ __forceinline__ void hgrn_seq(const Params& p, unsigned char* shm, int seq) {
    const int tid = otid(), lane = tid & 63, wave = tid >> 6, fr = lane & 15, fq = lane >> 4;
    const int h = seq & 7, b = seq >> 3;
    bf16_t* qS = (bf16_t*)shm;
    bf16_t* qe = qS + 32 * 136;
    bf16_t* ke = qe + 32 * 136;
    bf16_t* kST = ke + 32 * 136;
    bf16_t* vT = kST + 128 * 40;
    bf16_t* att = vT + 128 * 40;
    bf16_t* St = att + 32 * 40;
    float* offs = (float*)(St + 128 * 136);
    float* elast = offs + 512;
    float* red = elast + 128;
    const bf16_t* P = (const bf16_t*)(p.ws + OFF_PROJ);
    const float* FZ = (const float*)(p.ws + OFF_FZ);
    bf16_t* Ob = (bf16_t*)(p.ws + OFF_O);
    const int d = tid & 127, rg = tid >> 7;
    const float lb = ((const float*)(p.ws + OFF_LB))[h * 128 + d];
    f32x4 S[8];
#pragma unroll
    for (int tk = 0; tk < 8; ++tk) { S[tk] = (f32x4){0.f, 0.f, 0.f, 0.f}; *(u32x2*)(St + (wave * 16 + fr) * 136 + tk * 16 + 4 * fq) = (u32x2){0u, 0u}; }
    const f32x4 ng = *(const f32x4*)(p.hgrn_norm + wave * 16 + 4 * fq);
#pragma unroll 1
    for (int c = 0; c < 64; ++c) {
        const size_t r0 = (size_t)b * 2048 + c * 32;
        float lf[8], kk[8], qq[8], vv[8];
#pragma unroll
        for (int e = 0; e < 8; ++e) {
            const size_t r = r0 + rg * 8 + e;
            const float fz = FZ[r * 1024 + h * 128 + d];
            const float sg = 1.0f / (1.0f + expf(-fz)), sn = 1.0f / (1.0f + expf(fz));
            lf[e] = logf(lb + (1.0f - lb) * sg); kk[e] = (1.0f - lb) * sn;
            qq[e] = siluf_(bf2f(P[r * 4096 + h * 128 + d])); vv[e] = bf2f(P[r * 4096 + 2048 + h * 128 + d]);
        }
        float cs[8]; float run = 0.f;
#pragma unroll
        for (int e = 0; e < 8; ++e) { run += lf[e]; cs[e] = run; }
        __syncthreads();
        offs[rg * 128 + d] = run;
        __syncthreads();
        const float o0 = offs[d], o1 = offs[128 + d], o2 = offs[256 + d], o3 = offs[384 + d];
        const float base = rg == 0 ? 0.f : (rg == 1 ? o0 : (rg == 2 ? o0 + o1 : o0 + o1 + o2));
        const float tot = (o0 + o1) + (o2 + o3), bref = o0 + o1;
        u32x4 kw, vw;
#pragma unroll
        for (int e = 0; e < 8; e += 2) {
            kw[e >> 1] = cvt_pk_bf16(kk[e] * expf(tot - base - cs[e]), kk[e + 1] * expf(tot - base - cs[e + 1]));
            vw[e >> 1] = cvt_pk_bf16(vv[e], vv[e + 1]);
        }
        *(u32x4*)(kST + d * 40 + rg * 8) = kw; *(u32x4*)(vT + d * 40 + rg * 8) = vw;
#pragma unroll
        for (int e = 0; e < 8; ++e) {
            const float bc = base + cs[e]; const int i = rg * 8 + e;
            qS[i * 136 + d] = f2bf(qq[e] * expf(bc)); qe[i * 136 + d] = f2bf(qq[e] * expf(bc - bref)); ke[i * 136 + d] = f2bf(kk[e] * expf(bref - bc));
        }
        if (rg == 0) elast[d] = expf(tot);
        __syncthreads();
        if (wave < 4) {
            const int tj = wave >> 1, ti = wave & 1;
            f32x4 a = {0.f, 0.f, 0.f, 0.f};
#pragma unroll
            for (int ks = 0; ks < 4; ++ks) a = mfma16(*(const bf16x8*)(ke + (tj * 16 + fr) * 136 + ks * 32 + fq * 8), *(const bf16x8*)(qe + (ti * 16 + fr) * 136 + ks * 32 + fq * 8), a);
            const int i = ti * 16 + fr;
#pragma unroll
            for (int jj = 0; jj < 4; ++jj) { const int jx = tj * 16 + 4 * fq + jj; if (jx > i) a[jj] = 0.f; }
            *(u32x2*)(att + i * 40 + tj * 16 + 4 * fq) = pack4(a);
        }
        __syncthreads();
        bf16x8 sf[4];
#pragma unroll
        for (int ks = 0; ks < 4; ++ks) sf[ks] = *(const bf16x8*)(St + (wave * 16 + fr) * 136 + ks * 32 + fq * 8);
        const bf16x8 vf = *(const bf16x8*)(vT + (wave * 16 + fr) * 40 + fq * 8);
        f32x4 o[2];
#pragma unroll
        for (int ti = 0; ti < 2; ++ti) {
            f32x4 a = {0.f, 0.f, 0.f, 0.f};
#pragma unroll
            for (int ks = 0; ks < 4; ++ks) a = mfma16(sf[ks], *(const bf16x8*)(qS + (ti * 16 + fr) * 136 + ks * 32 + fq * 8), a);
            a = mfma16(vf, *(const bf16x8*)(att + (ti * 16 + fr) * 40 + fq * 8), a);
            o[ti] = a;
            float s2 = (a[0] * a[0] + a[1] * a[1]) + (a[2] * a[2] + a[3] * a[3]);
            s2 += __shfl_xor(s2, 16); s2 += __shfl_xor(s2, 32);
            if (fq == 0) red[wave * 32 + ti * 16 + fr] = s2;
        }
        __syncthreads();
#pragma unroll
        for (int ti = 0; ti < 2; ++ti) {
            const int i = ti * 16 + fr; float tt = 0.f;
#pragma unroll
            for (int w = 0; w < 8; ++w) tt += red[w * 32 + i];
            const float rn = rsqrtf(tt * (1.0f / 128.0f) + EPS);
            const size_t row = r0 + i;
            const f32x4 z = unpack4(*(const u32x2*)(P + row * 4096 + 3072 + h * 128 + wave * 16 + 4 * fq));
            f32x4 r;
#pragma unroll
            for (int jj = 0; jj < 4; ++jj) r[jj] = o[ti][jj] * rn * ng[jj] * siluf_(z[jj]);
            *(u32x2*)(Ob + row * 1024 + h * 128 + wave * 16 + 4 * fq) = pack4(r);
        }
#pragma unroll
        for (int tk = 0; tk < 8; ++tk) {
            const f32x4 el = *(const f32x4*)(elast + tk * 16 + 4 * fq);
            f32x4 a = S[tk] * el;
            a = mfma16(*(const bf16x8*)(kST + (tk * 16 + fr) * 40 + fq * 8), vf, a);
            S[tk] = a;
            *(u32x2*)(St + (wave * 16 + fr) * 136 + tk * 16 + 4 * fq) = pack4(a);
        }
    }
    float* ph = p.out + OUT_PH + (size_t)(b * 8 + h) * 16384;
#pragma unroll
    for (int tk = 0; tk < 8; ++tk)
#pragma unroll
        for (int jj = 0; jj < 4; ++jj) ph[(tk * 16 + 4 * fq + jj) * 128 + wave * 16 + fr] = S[tk][jj];
    __syncthreads();
}

__device__ __forceinline__ void hgrn_sample_item(const Params& p, unsigned char* shm, int item) {
    const int tid = otid(), lane = tid & 63, wave = tid >> 6;
    const int h = item & 7, b = item >> 3;
    const bf16_t* P = (const bf16_t*)(p.ws + OFF_PROJ);
    const float* FZ = (const float*)(p.ws + OFF_FZ);
    bf16_t* Ob = (bf16_t*)(p.ws + OFF_O);
    float* fs = (float*)shm; float* ks = fs + 512; float* qs = ks + 512; float* vs = qs + 512; float* red = vs + 512; float* part = red + 512;
    const int t = tid >> 7, d = tid & 127;
    __syncthreads();
    {
        const size_t r = MP + b * 4 + t;
        const float lb = ((const float*)(p.ws + OFF_LB))[h * 128 + d];
        const float fz = FZ[r * 1024 + h * 128 + d];
        const float sg = 1.0f / (1.0f + expf(-fz)), sn = 1.0f / (1.0f + expf(fz));
        fs[tid] = lb + (1.0f - lb) * sg; ks[tid] = (1.0f - lb) * sn;
        qs[tid] = siluf_(bf2f(P[r * 4096 + h * 128 + d])); vs[tid] = bf2f(P[r * 4096 + 2048 + h * 128 + d]);
    }
    __syncthreads();
    const int dv = tid & 127, grp = tid >> 7;
    float s[32];
    const float* sp = p.state_hgrn + (size_t)(b * 8 + h) * 16384;
#pragma unroll
    for (int e = 0; e < 32; ++e) s[e] = sp[(grp * 32 + e) * 128 + dv];
#pragma unroll 1
    for (int tt = 0; tt < 4; ++tt) {
        const float v = vs[tt * 128 + dv]; float o = 0.f;
#pragma unroll
        for (int e = 0; e < 32; ++e) { const int dk = tt * 128 + grp * 32 + e; s[e] = fs[dk] * s[e] + ks[dk] * v; o += s[e] * qs[dk]; }
        red[grp * 128 + dv] = o;
        __syncthreads();
        const float ot = (red[dv] + red[128 + dv]) + (red[256 + dv] + red[384 + dv]);
        const float so = wave_sum(ot * ot);
        if (lane == 0) part[wave] = so;
        __syncthreads();
        const float rn = rsqrtf((part[2 * grp] + part[2 * grp + 1]) * (1.0f / 128.0f) + EPS);
        if (grp == 0) {
            const size_t row = MP + b * 4 + tt;
            const float z = bf2f(P[row * 4096 + 3072 + h * 128 + dv]);
            Ob[row * 1024 + h * 128 + dv] = f2bf(ot * rn * p.hgrn_norm[dv] * siluf_(z));
        }
        __syncthreads();
    }
    float* sh = p.out + OUT_SH + (size_t)(b * 8 + h) * 16384;
#pragma unroll
    for (int e = 0; e < 32; ++e) sh[(grp * 32 + e) * 128 + dv] = s[e];
}

__device__ __forceinline__ void run_phase(const Params& p, unsigned char* shm, int code) {

#ifndef NO_PRO
    if (code == 0xF0) { ph_prologue(p, shm); return; }
#endif

    if (code == 0xF1) { ph_final(p); return; }
    const int layer = code >> 4, sub = code & 15, kind = layer % 3, jm = layer / 3;
    float* SS = (float*)(p.ws + OFF_SS);
    bf16_t* XG = (bf16_t*)(p.ws + OFF_XG); bf16_t* HID = (bf16_t*)(p.ws + OFF_HID); bf16_t* PROJ = (bf16_t*)(p.ws + OFF_PROJ); bf16_t* Ob = (bf16_t*)(p.ws + OFF_O);
    PG8_LAS unsigned char* lds = (PG8_LAS unsigned char*)shm;
    pg8::StaticOrder so;
    if (sub == 0 || sub == 6) {
        const int s = sub == 0 ? 0 : 1;
        pg8::Gemm g; g.A = XG; g.Bt = (const bf16_t*)(p.ws + WT_FFN_IN) + (size_t)(layer * 2 + s) * 5632 * 1024; g.M = M_TOK; g.N = 5632; g.K = 1024;
        EpiSwiglu e; e.H = HID; e.ss = SS + (size_t)((3 * layer + (s ? 2 : 0)) & 1) * M_TOK * 16;
        so.init(g.M, g.N, gridDim.x, obid());

#ifndef NO_GE1
 pg8::gemm_phase<EpiSwiglu, pg8::StaticOrder, false>(lds, g, so, e, nullptr);
#endif

    } else if (sub == 1 || sub == 5 || sub == 7) {
        pg8::Gemm g; EpiResid e; e.X = p.out; e.XG = XG; g.M = M_TOK; g.N = 1024;
        if (sub == 1) { g.A = HID; g.K = DFF; g.Bt = (const bf16_t*)(p.ws + WT_FFN_OUT) + (size_t)(layer * 2) * 1024 * DFF; e.scale = 0.5f; e.g = p.norm_mix + layer * 1024; e.ssn = SS + (size_t)((3 * layer + 1) & 1) * M_TOK * 16; }
        else if (sub == 7) { g.A = HID; g.K = DFF; g.Bt = (const bf16_t*)(p.ws + WT_FFN_OUT) + (size_t)(layer * 2 + 1) * 1024 * DFF; e.scale = 0.5f; e.g = layer < 3 ? p.norm_ffn + (size_t)((layer + 1) * 2) * 1024 : p.final_norm; e.ssn = SS + (size_t)((3 * layer + 3) & 1) * M_TOK * 16; }
        else { g.A = Ob; e.scale = 1.0f; e.g = p.norm_ffn + (size_t)(layer * 2 + 1) * 1024; e.ssn = SS + (size_t)((3 * layer + 2) & 1) * M_TOK * 16;
            if (kind == 0) { g.K = 1024; g.Bt = (const bf16_t*)(p.ws + WT_SWA_OUT) + (size_t)jm * 1024 * 1024; }
            else if (kind == 1) { g.K = 2048; g.Bt = (const bf16_t*)(p.ws + WT_GDN_OUT); }
            else { g.K = 1024; g.Bt = (const bf16_t*)(p.ws + WT_HG_OUT); } }
        so.init(g.M, g.N, gridDim.x, obid());

#ifndef NO_GE2
 pg8::gemm_phase<EpiResid, pg8::StaticOrder, false>(lds, g, so, e, nullptr);
#endif

    } else if (sub == 2) {
        pg8::Gemm g; g.A = XG; g.M = M_TOK; g.K = 1024; EpiProj e; e.P = PROJ; e.ss = SS + (size_t)((3 * layer + 1) & 1) * M_TOK * 16; e.mode = kind; e.rope = (const float*)(p.ws + OFF_ROPE);
        if (kind == 0) { g.N = 1536; g.Bt = (const bf16_t*)(p.ws + WT_SWA_IN) + (size_t)jm * 1536 * 1024; e.side = nullptr; }
        else if (kind == 1) { g.N = 6400; g.Bt = (const bf16_t*)(p.ws + WT_GDN_IN); e.side = (float*)(p.ws + OFF_BA); }
        else { g.N = 4096; g.Bt = (const bf16_t*)(p.ws + WT_HG_IN); e.side = (float*)(p.ws + OFF_FZ); }
        e.ld = g.N;
        so.init(g.M, g.N, gridDim.x, obid());

#ifndef NO_GE3
 pg8::gemm_phase<EpiProj, pg8::StaticOrder, false>(lds, g, so, e, nullptr);
#endif

    } else if (sub == 3) {
        if (kind == 0) {
            for (int it = obid(); it < 1024; it += gridDim.x) {
#ifndef NO_SWAP
 if (it < 512) swa_prompt_item(p, shm, jm, it);
#endif
#ifndef NO_SWAS
 if (it >= 512) swa_sample_item(p, shm, jm, it - 512);
#endif
 }
        } else if (kind == 1) {

#ifndef NO_G1
 for (int u = obid(); u < 4096; u += gridDim.x) gdn_g1_unit(p, shm, u);
#endif

        } else {

#ifndef NO_HG
 if (obid() < 64) hgrn_seq(p, shm, obid());
#endif


#ifndef NO_HGS
 if (obid() >= 64) for (int it = obid() - 64; it < 1024; it += gridDim.x - 64) hgrn_sample_item(p, shm, it);
#endif

        }
    } else if (sub == 4) {

#ifndef NO_G2
 if (obid() < 128) gdn_g2_seq(p, shm, obid());
#endif


#ifndef NO_GS
 if (obid() >= 128) for (int it = obid() - 128; it < 2048; it += gridDim.x - 128) gdn_sample_item(p, shm, it);
#endif

    }
}

__global__ __launch_bounds__(512, 2) void mega(Params p, int ph_lo, int ph_hi) {
    extern __shared__ __attribute__((aligned(16))) unsigned char shm[];
    cg::grid_group grid = cg::this_grid();
    for (int ph = ph_lo; ph < ph_hi; ++ph) {
        run_phase(p, shm, p.prog[ph]);
        if (ph + 1 < ph_hi) grid.sync();
    }
}

extern "C" void kernel_launch(void* const* d_in, const int* in_sizes, int n_in, void* d_out, int out_size, void* d_ws, size_t ws_size, hipStream_t stream) {
    static int grid_blocks = 0;
    if (grid_blocks == 0) {
        if (n_in != 25 || (size_t)out_size != OUT_END || ws_size < WS_END) { fprintf(stderr, "kernel_launch: unexpected shapes n_in %d out %d ws %zu (need %zu)\n", n_in, out_size, ws_size, (size_t)WS_END); grid_blocks = -1; return; }
        int dev = 0, cus = 0, per_cu = 0;
        hipGetDevice(&dev); hipDeviceGetAttribute(&cus, hipDeviceAttributeMultiprocessorCount, dev);
        if (hipFuncSetAttribute((const void*)mega, hipFuncAttributeMaxDynamicSharedMemorySize, LDS_BYTES) != hipSuccess) { fprintf(stderr, "kernel_launch: hipFuncSetAttribute failed\n"); grid_blocks = -1; return; }
        if (hipOccupancyMaxActiveBlocksPerMultiprocessor(&per_cu, (const void*)mega, 512, LDS_BYTES) != hipSuccess || per_cu < 1) { fprintf(stderr, "kernel_launch: occupancy query gave %d\n", per_cu); per_cu = 1; }
        (void)hipGetLastError();
        grid_blocks = cus * 1;
    }
    if (grid_blocks < 0) return;
    Params p{};
    const float** f = (const float**)&p.x_prompt;
    for (int i = 0; i < 25; ++i) f[i] = (const float*)d_in[i];
    p.out = (float*)d_out; p.ws = (unsigned char*)d_ws;
    for (int i = 0; i < 8; ++i) p.inv_freq[i] = (float)pow(500000.0, -(double)i / 8.0);
    {
        int n = 0, t0 = 0; unsigned char* ws = (unsigned char*)d_ws;
        auto add = [&](const float* src, size_t dst_off, int K, int N, int Nrows, int mode) { WD& w = p.wd[n++]; w.src = src; w.dst = (bf16_t*)(ws + dst_off); w.K = K; w.N = N; w.Nrows = Nrows; w.mode = mode; w.tile0 = t0; w.pad = 0; t0 += (K / 128) * (Nrows / 64); };
        for (int i = 0; i < 8; ++i) add(p.ffn_w_in + (size_t)i * 1024 * 5632, WT_FFN_IN + (size_t)i * 5632 * 1024 * 2, 1024, 5632, 5632, 1);
        for (int i = 0; i < 8; ++i) add(p.ffn_w_out + (size_t)i * DFF * 1024, WT_FFN_OUT + (size_t)i * 1024 * DFF * 2, DFF, 1024, 1024, 0);
        for (int i = 0; i < 2; ++i) add(p.swa_w_in + (size_t)i * 1024 * 1536, WT_SWA_IN + (size_t)i * 1536 * 1024 * 2, 1024, 1536, 1536, 0);
        for (int i = 0; i < 2; ++i) add(p.swa_w_out + (size_t)i * 1024 * 1024, WT_SWA_OUT + (size_t)i * 1024 * 1024 * 2, 1024, 1024, 1024, 0);
        add(p.gdn_w_in, WT_GDN_IN, 1024, 6176, 6400, 0);
        add(p.gdn_w_out, WT_GDN_OUT, 2048, 1024, 1024, 0);
        add(p.hgrn_w_in, WT_HG_IN, 1024, 4096, 4096, 0);
        add(p.hgrn_w_out, WT_HG_OUT, 1024, 1024, 1024, 0);
        p.wd_total = t0;
    }
    {
        int n = 0; p.prog[n++] = 0xF0;
        for (int l = 0; l < NLAYERS; ++l) for (int s = 0; s < 8; ++s) { if (s == 4 && (l % 3) != 1) continue; p.prog[n++] = (unsigned char)(l * 16 + s); }
        p.prog[n++] = 0xF1; p.nprog = n;
    }
#if MULTI_LAUNCH
    for (int ph = 0; ph < p.nprog; ++ph) hipLaunchKernelGGL(mega, dim3(grid_blocks), dim3(512), LDS_BYTES, stream, p, ph, ph + 1);
#else
    int lo = 0, hi = p.nprog;
    void* args[] = {&p, &lo, &hi};
    hipError_t e = hipLaunchCooperativeKernel((const void*)mega, dim3(grid_blocks), dim3(512), args, LDS_BYTES, stream);
    if (e != hipSuccess) fprintf(stderr, "kernel_launch: cooperative launch failed: %s\n", hipGetErrorString(e));
#endif
}
```

```cpp
#include <hip/hip_runtime.h>
#include <hip/hip_cooperative_groups.h>
#include <cstdio>
#include <cmath>
namespace cg = cooperative_groups;
namespace pg8 {
#define PG8_LAS __attribute__((address_space(3)))
typedef unsigned short bf16_t;
typedef short bf16x8 __attribute__((ext_vector_type(8)));
typedef float f32x4 __attribute__((ext_vector_type(4)));
typedef unsigned u32x4 __attribute__((ext_vector_type(4)));
constexpr int BM = 256, BK = 64, HALF = 128, HTB = HALF * BK * 2  , STAGE_BYTES = 8 * HTB, NXCD = 8, WGM = 8;

__host__ __device__ __forceinline__ int lds_byte(int r, int c) { const int st = (r >> 4) * 2 + (c >> 5), rr = r & 15, cc = c & 31, ob = rr * 64 + cc * 2; return st * 1024 + (ob ^ (((ob >> 9) & 1) << 5)); }
__host__ __device__ __forceinline__ void stage_rc(int b, int& R, int& C) { const int st = b / 1024, sb = b % 1024, swz = sb ^ (((sb >> 9) & 1) << 5); R = (st >> 1) * 16 + swz / 64; C = (st & 1) * 32 + (swz % 64) / 2; }
__host__ __device__ __forceinline__ int perm32(int rho) { const int n = rho >> 4, i = rho & 15; return 8 * (i >> 2) + 4 * n + (i & 3); }

struct Unit { int pm, pn, idx; };
struct Gemm { const bf16_t* A; const bf16_t* Bt; int M, N, K, ld; };

struct StaticOrder {
    int nM, nN, nwg, G, c;
    __host__ __device__ void init(int M, int N, int G_, int c_) { nM = M / BM; nN = N / BM; nwg = nM * nN; G = G_; c = c_; }
    __host__ __device__ bool next(int i, Unit& u) const {
        const long L = (long)i * G + c; if (L >= nwg) return false;
        int wgid = (int)L; { const int q = nwg / NXCD, r = nwg % NXCD, xcd = wgid % NXCD, off = wgid / NXCD; wgid = (xcd < r ? xcd * (q + 1) : r * (q + 1) + (xcd - r) * q) + off; }
        const int nig = WGM * nN, gid = wgid / nig, fm = gid * WGM, gsz = (nM - fm) < WGM ? (nM - fm) : WGM;
        u.pm = fm + ((wgid % nig) % gsz); u.pn = (wgid % nig) / gsz; u.idx = i; return true;
    }
    __device__ __forceinline__ void a_ready(const Unit&) const {}
    __device__ __forceinline__ void done(const Unit&) const {}
};
typedef __bf16 bf16v2_t __attribute__((ext_vector_type(2)));
__device__ __forceinline__ unsigned cvt_pk_bf16(float lo, float hi) { float __attribute__((ext_vector_type(2))) v = {lo, hi}; return __builtin_bit_cast(unsigned, __builtin_convertvector(v, bf16v2_t)); }
typedef float f32x2 __attribute__((ext_vector_type(2)));
template <class Epi, class Sched, bool STAMP = false>
__device__ __forceinline__ void gemm_phase(PG8_LAS unsigned char* lds, const Gemm g, const Sched& S, const Epi& E, unsigned long long* stamps) {
    int tid_ = threadIdx.x; asm volatile("" : "+v"(tid_)); const int tid = tid_, wid = __builtin_amdgcn_readfirstlane(tid >> 6), lane = tid & 63, wr = wid >> 2, wc = wid & 3, fr = lane & 15, fq = lane >> 4;
    const int K = g.K, nt = K / BK, LD = g.ld;
    int ts_lo = 0, ts_hi = 0, nts = 0; const unsigned long long rt_entry = STAMP ? (unsigned long long)wall_clock64() : 0ull;
#define PG8_STAMP() do { if (STAMP && wid == 0 && nts < 64) { const unsigned long long _c = (unsigned long long)clock64(); \
        ts_lo = (lane == nts) ? (int)(unsigned)_c : ts_lo; ts_hi = (lane == nts) ? (int)(unsigned)(_c >> 32) : ts_hi; ++nts; } } while (0)
    PG8_STAMP();
    unsigned voffA[2], voffB[2];
#pragma unroll
    for (int i = 0; i < 2; ++i) { int R, C; stage_rc(tid * 16 + i * 8192, R, C); const int Rb = Epi::PERM ? ((R & ~31) + perm32(R & 31)) : R;
        voffA[i] = (unsigned)(R * LD + C) * 2u; voffB[i] = (unsigned)(Rb * LD + C) * 2u; }
    const size_t kstep = (size_t)(BK * 2);
    const size_t hstep = (size_t)HALF * LD * 2;
    const size_t tstep = 2 * hstep;
    const unsigned ldsw = (unsigned)wid * 1024u;
    const int aoff = lds_byte(wr * 64 + fr, fq * 8), boff = lds_byte(wc * 32 + fr, fq * 8);
#define PG8_SA(b, h) (((b) * 2 + (h)) * HTB)
#define PG8_SB(b, h) ((4 + (b) * 2 + (h)) * HTB)
#define PG8_STAGE(bufoff, gbase, voff) do { _Pragma("unroll") for (int _i = 0; _i < 2; ++_i) \
        __builtin_amdgcn_global_load_lds((const unsigned*)((const char*)(gbase) + (voff)[_i]), (PG8_LAS unsigned*)(lds + (bufoff) + ldsw + _i * 8192), 16, 0, 0); } while (0)
#define PG8_LDA(dst, b, h) do { _Pragma("unroll") for (int m = 0; m < 4; ++m) _Pragma("unroll") for (int k = 0; k < 2; ++k) dst[m][k] = *(const PG8_LAS bf16x8*)(lds + PG8_SA(b, h) + aoff + m * 2048 + k * 1024); } while (0)
#define PG8_LDB(dst, b, h) do { _Pragma("unroll") for (int n = 0; n < 2; ++n) _Pragma("unroll") for (int k = 0; k < 2; ++k) dst[n][k] = *(const PG8_LAS bf16x8*)(lds + PG8_SB(b, h) + boff + n * 2048 + k * 1024); } while (0)
#define PG8_MMA(ai, bj, At, Bt) do { __builtin_amdgcn_s_setprio(1); _Pragma("unroll") for (int m = 0; m < 4; ++m) _Pragma("unroll") for (int n = 0; n < 2; ++n) _Pragma("unroll") for (int k = 0; k < 2; ++k) \
        acc[ai][bj][m][n] = __builtin_amdgcn_mfma_f32_16x16x32_bf16(Bt[n][k], At[m][k], acc[ai][bj][m][n], 0, 0, 0); __builtin_amdgcn_s_setprio(0); } while (0)
#define PG8_WAIT_V(n) asm volatile("s_waitcnt vmcnt(" #n ")" ::: "memory")
#define PG8_WAIT_L(n) asm volatile("s_waitcnt lgkmcnt(" #n ")" ::: "memory")
#define PG8_BAR __builtin_amdgcn_s_barrier()
#define PG8_SCHED __builtin_amdgcn_sched_barrier(0)
    Unit cur, nxt; int ui = 0;
    if (!S.next(0, cur)) return;
    f32x4 acc[2][2][4][2];
    if constexpr (Epi::HAS_INIT) E.init(acc, cur, wr, wc, fr, fq);
    else {
#pragma unroll
    for (int a = 0; a < 2; ++a)
#pragma unroll
        for (int b = 0; b < 2; ++b)
#pragma unroll
            for (int m = 0; m < 4; ++m)
#pragma unroll
                for (int n = 0; n < 2; ++n) acc[a][b][m][n] = (f32x4){0.f, 0.f, 0.f, 0.f};
    }
    bf16x8 At[4][2], B0[2][2], B1[2][2];
    const char* cA = (const char*)g.A + (size_t)cur.pm * tstep; const char* cB = (const char*)g.Bt + (size_t)cur.pn * tstep;
    S.a_ready(cur);
    PG8_STAGE(PG8_SB(0, 0), cB, voffB); PG8_STAGE(PG8_SA(0, 0), cA, voffA); PG8_STAGE(PG8_SB(0, 1), cB + hstep, voffB); PG8_STAGE(PG8_SA(0, 1), cA + hstep, voffA);
    if (wr == 1) PG8_BAR;
    PG8_WAIT_V(4); PG8_BAR;
    PG8_STAGE(PG8_SB(1, 0), cB + kstep, voffB); PG8_STAGE(PG8_SA(1, 0), cA + kstep, voffA); PG8_STAGE(PG8_SB(1, 1), cB + hstep + kstep, voffB);
    PG8_WAIT_V(6); PG8_BAR;
    PG8_STAMP();
    for (;;) {
        const bool has_next = S.next(ui + 1, nxt);
        const char* nA = has_next ? (const char*)g.A + (size_t)nxt.pm * tstep : cA; const char* nB = has_next ? (const char*)g.Bt + (size_t)nxt.pn * tstep : cB;
        for (int t = 0; t < nt; t += 2) {
            const bool last = (t == nt - 2);
            const char* a1 = cA + (size_t)(t + 1) * kstep;
            const char* a2 = last ? nA : cA + (size_t)(t + 2) * kstep; const char* b2 = last ? nB : cB + (size_t)(t + 2) * kstep;
            const char* a3 = a2 + kstep; const char* b3 = b2 + kstep;
            if (last && has_next) S.a_ready(nxt);
            PG8_LDB(B0, 0, 0); PG8_SCHED; PG8_LDA(At, 0, 0); PG8_STAGE(PG8_SA(1, 1), a1 + hstep, voffA);
            PG8_WAIT_L(8); PG8_BAR; PG8_WAIT_L(0); PG8_MMA(0, 0, At, B0); PG8_BAR; PG8_SCHED;
            PG8_LDB(B1, 0, 1); PG8_STAGE(PG8_SB(0, 0), b2, voffB);
            PG8_BAR; PG8_WAIT_L(0); PG8_MMA(0, 1, At, B1); PG8_BAR;
            PG8_LDA(At, 0, 1); PG8_STAGE(PG8_SA(0, 0), a2, voffA);
            PG8_BAR; PG8_WAIT_L(0); PG8_MMA(1, 0, At, B0); PG8_BAR; PG8_SCHED;
            PG8_STAGE(PG8_SB(0, 1), b2 + hstep, voffB);
            PG8_WAIT_V(6); PG8_BAR; PG8_MMA(1, 1, At, B1); PG8_BAR;
            PG8_LDB(B0, 1, 0); PG8_SCHED; PG8_LDA(At, 1, 0); PG8_STAGE(PG8_SA(0, 1), a2 + hstep, voffA);
            PG8_WAIT_L(8); PG8_BAR; PG8_WAIT_L(0); PG8_MMA(0, 0, At, B0); PG8_BAR; PG8_SCHED;
            PG8_LDB(B1, 1, 1); PG8_STAGE(PG8_SB(1, 0), b3, voffB);
            PG8_BAR; PG8_WAIT_L(0); PG8_MMA(0, 1, At, B1); PG8_BAR;
            PG8_LDA(At, 1, 1); PG8_STAGE(PG8_SA(1, 0), a3, voffA);
            PG8_BAR; PG8_WAIT_L(0); PG8_MMA(1, 0, At, B0); PG8_BAR; PG8_SCHED;
            PG8_STAGE(PG8_SB(1, 1), b3 + hstep, voffB);
            PG8_WAIT_V(6); PG8_BAR; PG8_MMA(1, 1, At, B1); PG8_BAR;
        }
        PG8_STAMP();
        if constexpr (!Epi::AFTER_DRAIN) { E(acc, cur, wr, wc, fr, fq); S.done(cur); }
        PG8_STAMP();
        if (!has_next) break;
        if constexpr (Epi::HAS_INIT) E.init(acc, nxt, wr, wc, fr, fq);
        else {
#pragma unroll
        for (int a = 0; a < 2; ++a)
#pragma unroll
            for (int b = 0; b < 2; ++b)
#pragma unroll
                for (int m = 0; m < 4; ++m)
#pragma unroll
                    for (int n = 0; n < 2; ++n) acc[a][b][m][n] = (f32x4){0.f, 0.f, 0.f, 0.f};
        }
        cur = nxt; cA = nA; cB = nB; ++ui;
    }
    PG8_WAIT_V(0);
    if (wr == 0) PG8_BAR;
    PG8_BAR;
    if constexpr (Epi::AFTER_DRAIN) { E.fused(acc, cur, wr, wc, fr, fq, lds, wid, lane); S.done(cur); }
    PG8_STAMP();
    if (STAMP && wid == 0) { stamps[lane] = lane < nts ? (((unsigned long long)(unsigned)ts_hi << 32) | (unsigned)ts_lo) : 0ull;
        if (lane == 62) stamps[62] = rt_entry; if (lane == 63) stamps[63] = (unsigned long long)wall_clock64(); }
#undef PG8_STAMP
#undef PG8_SA
#undef PG8_SB
#undef PG8_STAGE
#undef PG8_LDA
#undef PG8_LDB
#undef PG8_MMA
#undef PG8_WAIT_V
#undef PG8_WAIT_L
#undef PG8_BAR
#undef PG8_SCHED
}
}

#define XB_TMO      128
#define XB_XCNT(j)  (256  + 64 * (j))
#define XB_XSUB(j)  (1280 + 64 * (j))
#define XB_XGEN(j)  (2304 + 64 * (j))
#define XB_TOP      3328
#define XB_TOPGEN   3392
#define XCD_BAR_WORDS 3456
#define XB_SPIN_CAP (1u << 18)
#ifndef LAS
#define LAS __attribute__((address_space(3)))
#endif

__device__ __forceinline__ unsigned xb_ld(unsigned* p)              { return __hip_atomic_load(p, __ATOMIC_RELAXED, __HIP_MEMORY_SCOPE_AGENT); }
__device__ __forceinline__ unsigned xb_add(unsigned* p, unsigned v) { return __hip_atomic_fetch_add(p, v, __ATOMIC_RELAXED, __HIP_MEMORY_SCOPE_AGENT); }
__device__ __forceinline__ unsigned xb_xcc_id() { return (unsigned)__builtin_amdgcn_s_getreg((3 << 11) | 20) & 0xFu; }
#define XB_SPIN(cond, bar) do { unsigned _sp = 0; while (cond) { __builtin_amdgcn_s_sleep(1); \
    if ((++_sp & 255u) == 0u) { if (xb_ld(&(bar)[XB_TMO])) break; if (_sp > XB_SPIN_CAP) { atomicAdd(&(bar)[XB_TMO], 1u); break; } } } } while (0)

struct XcdBarrier {
    unsigned* bar; unsigned x;
    volatile LAS unsigned* st;
};

__device__ __forceinline__ XcdBarrier xcd_barrier_post(unsigned* bar, volatile LAS unsigned* st) {
    XcdBarrier b; b.bar = bar; b.x = xb_xcc_id(); b.st = st;
    if (threadIdx.x == 0) (void)xb_add(&bar[XB_XCNT(b.x)], 1u);
    return b;
}
__device__ __forceinline__ void xcd_barrier_complete(unsigned* bar, unsigned x, unsigned& nloc, unsigned& nx) {
    const unsigned G = gridDim.x * gridDim.y * gridDim.z;
    unsigned sum, cnt, mine, sp = 0u;
    for (;;) {
        sum = 0u; cnt = 0u; mine = 0u;
#pragma unroll
        for (unsigned j = 0; j < 16; ++j) { const unsigned c = xb_ld(&bar[XB_XCNT(j)]); sum += c; cnt += (c > 0u) ? 1u : 0u; mine = (j == x) ? c : mine; }
        if (sum == G) break;
        __builtin_amdgcn_s_sleep(1);
        if ((++sp & 255u) == 0u) { if (xb_ld(&bar[XB_TMO])) break; if (sp > XB_SPIN_CAP) { atomicAdd(&bar[XB_TMO], 1u); break; } }
    }
    nloc = mine > 0u ? mine : 1u; nx = cnt > 0u ? cnt : 1u;
}

__device__ __forceinline__ void xcd_barrier(const XcdBarrier& b) {
    asm volatile("s_waitcnt vmcnt(0)" ::: "memory");
    __syncthreads();
    if (threadIdx.x == 0) {
        unsigned* bar = b.bar;
        __builtin_amdgcn_s_waitcnt(0);
        unsigned nloc = b.st[0], nx = b.st[1];
        if (nloc == 0u) { xcd_barrier_complete(bar, b.x, nloc, nx); b.st[0] = nloc; b.st[1] = nx; }
        const unsigned old = xb_add(&bar[XB_XSUB(b.x)], 1u);
        const unsigned gen = old / nloc;
        if (old + 1u == (gen + 1u) * nloc) {
            __builtin_amdgcn_fence(__ATOMIC_RELEASE, "agent");
            asm volatile("s_waitcnt vmcnt(0)" ::: "memory");
            const unsigned og = xb_add(&bar[XB_TOP], 1u);
            const unsigned tg = og / nx;
            if (og + 1u == (tg + 1u) * nx) xb_add(&bar[XB_TOPGEN], 1u);
            else XB_SPIN(xb_ld(&bar[XB_TOPGEN]) == tg, bar);
            __builtin_amdgcn_fence(__ATOMIC_ACQUIRE, "agent");
            xb_add(&bar[XB_XGEN(b.x)], 1u);
            asm volatile("s_waitcnt vmcnt(0)" ::: "memory");
        } else {
            XB_SPIN(xb_ld(&bar[XB_XGEN(b.x)]) == gen, bar);
            __builtin_amdgcn_fence(__ATOMIC_ACQUIRE, "agent");
            asm volatile("s_waitcnt vmcnt(0)" ::: "memory");
        }
    }
    __syncthreads();
}

using pg8::f32x2; using pg8::bf16_t; using pg8::bf16x8; using pg8::f32x4; using pg8::u32x4; using pg8::Unit; using pg8::cvt_pk_bf16;
typedef unsigned u32x2 __attribute__((ext_vector_type(2)));
typedef short bf16x4 __attribute__((ext_vector_type(4)));

#ifndef NLAYERS
#define NLAYERS 4
#endif
#ifndef REP_GEMM
#define REP_GEMM 0
#endif
#ifndef REP_CORE
#define REP_CORE 0
#endif
#ifndef REP_PRO
#define REP_PRO 0
#endif
#ifndef USE_SPLIT
#define USE_SPLIT 0
#endif
#ifndef REP_SYNC
#define REP_SYNC 0
#endif
#ifndef G1_PAIR
#define G1_PAIR 1
#endif
#ifndef GS_EARLY
#define GS_EARLY 0
#endif
#ifndef MULTI_LAUNCH
#define MULTI_LAUNCH 0
#endif

constexpr int M_TOK = 16896, MP = 16384, DM = 1024, DFF = 2816;
constexpr float EPS = 1e-6f;
constexpr int LDS_PHASE = 147456;
constexpr int LDS_BYTES = LDS_PHASE + 256;

constexpr size_t OUT_Y = 0;
constexpr size_t OUT_PK = (size_t)M_TOK * 1024;
constexpr size_t OUT_PV = OUT_PK + 2 * 8 * 128 * 256;
constexpr size_t OUT_PG = OUT_PV + 2 * 8 * 128 * 256;
constexpr size_t OUT_PC = OUT_PG + (size_t)8 * 16 * 128 * 128;
constexpr size_t OUT_PH = OUT_PC + 8 * 3 * 4096;
constexpr size_t OUT_SK = OUT_PH + (size_t)8 * 8 * 128 * 128;
constexpr size_t OUT_SV = OUT_SK + (size_t)2 * 128 * 128 * 256;
constexpr size_t OUT_SG = OUT_SV + (size_t)2 * 128 * 128 * 256;
constexpr size_t OUT_SC = OUT_SG + (size_t)128 * 16 * 128 * 128;
constexpr size_t OUT_SH = OUT_SC + (size_t)128 * 3 * 4096;
constexpr size_t OUT_END = OUT_SH + (size_t)128 * 8 * 128 * 128;

constexpr size_t WT_FFN_IN = 0;
constexpr size_t WT_FFN_OUT = WT_FFN_IN + (size_t)8 * 5632 * 1024 * 2;
constexpr size_t WT_SWA_IN = WT_FFN_OUT + (size_t)8 * 1024 * 2816 * 2;
constexpr size_t WT_SWA_OUT = WT_SWA_IN + (size_t)2 * 1536 * 1024 * 2;
constexpr size_t WT_GDN_IN = WT_SWA_OUT + (size_t)2 * 1024 * 1024 * 2;
constexpr size_t WT_GDN_OUT = WT_GDN_IN + (size_t)6400 * 1024 * 2;
constexpr size_t WT_HG_IN = WT_GDN_OUT + (size_t)1024 * 2048 * 2;
constexpr size_t WT_HG_OUT = WT_HG_IN + (size_t)4096 * 1024 * 2;
constexpr size_t OFF_XG = WT_HG_OUT + (size_t)1024 * 1024 * 2;
constexpr size_t OFF_HID = OFF_XG + (size_t)M_TOK * 1024 * 2;
constexpr size_t OFF_PROJ = OFF_HID + (size_t)M_TOK * 2816 * 2;
constexpr size_t OFF_O = OFF_PROJ + (size_t)M_TOK * 6400 * 2;
constexpr size_t OFF_SS = OFF_O + (size_t)M_TOK * 2048 * 2;
constexpr size_t OFF_BA = OFF_SS + (size_t)2 * M_TOK * 16 * 4;
constexpr size_t OFF_ROPE = OFF_BA + (size_t)M_TOK * 32 * 4;
constexpr size_t OFF_LB = OFF_ROPE + (size_t)2052 * 16 * 4;
constexpr size_t OFF_CNT = OFF_LB + 4096;
constexpr size_t OFF_BAR = OFF_CNT + 4096;
constexpr size_t OFF_GW = OFF_BAR + 16384;
constexpr size_t OFF_GUT = OFF_GW + (size_t)4096 * 8192 * 2;
constexpr size_t WS_END = OFF_GUT + (size_t)4096 * 8192 * 2;
constexpr size_t OFF_QN = OFF_XG;
constexpr size_t OFF_KN = OFF_QN + (size_t)2048 * 8192 * 2;
constexpr size_t OFF_ATT = OFF_KN + (size_t)2048 * 8192 * 2;
constexpr size_t OFF_GCUM = OFF_ATT + (size_t)4096 * 4096 * 2;
static_assert(OFF_GCUM + 4096 * 64 * 4 <= OFF_PROJ, "alias overflow");
constexpr size_t OFF_PART = OFF_PROJ;
constexpr size_t OFF_FZ = OFF_PROJ + (size_t)M_TOK * 4096 * 2;
static_assert(OFF_FZ + (size_t)M_TOK * 1024 * 4 <= OFF_O, "fz overflow");

struct WD { const float* src; bf16_t* dst; int K, N, Nrows, mode, tile0, pad; };
constexpr int NWD = 24;

struct Params {
    const float *x_prompt, *x_sample, *cache_k, *cache_v, *state_gdn, *state_conv, *state_hgrn;
    const float *norm_ffn, *ffn_w_in, *ffn_w_out, *norm_mix, *swa_w_in, *swa_w_out, *swa_sinks;
    const float *gdn_w_in, *gdn_conv_w, *gdn_a_log, *gdn_dt_bias, *gdn_norm, *gdn_w_out;
    const float *hgrn_w_in, *hgrn_lb, *hgrn_norm, *hgrn_w_out, *final_norm;
    float* out; unsigned char* ws;
    float inv_freq[8];
    WD wd[NWD];
    int wd_total, nprog;
    int wg_desc[14], wg_tile[14];
    unsigned char prog[80];
};

__device__ __forceinline__ int otid() { int t = threadIdx.x; asm volatile("" : "+v"(t)); return t; }
__device__ __forceinline__ int obid() { int b = blockIdx.x; asm volatile("" : "+s"(b)); return b; }

__device__ __forceinline__ float bf2f(bf16_t b) { return __uint_as_float(((unsigned)b) << 16); }
__device__ __forceinline__ float bflo(unsigned w) { return __uint_as_float(w << 16); }
__device__ __forceinline__ float bfhi(unsigned w) { return __uint_as_float(w & 0xffff0000u); }
__device__ __forceinline__ bf16_t f2bf(float f) { return (bf16_t)(cvt_pk_bf16(f, 0.f) & 0xffffu); }
__device__ __forceinline__ u32x2 pack4(f32x4 v) { u32x2 r; r.x = cvt_pk_bf16(v[0], v[1]); r.y = cvt_pk_bf16(v[2], v[3]); return r; }
__device__ __forceinline__ f32x4 unpack4(u32x2 w) { f32x4 r; r[0] = bflo(w.x); r[1] = bfhi(w.x); r[2] = bflo(w.y); r[3] = bfhi(w.y); return r; }
__device__ __forceinline__ float fast_exp(float x) { return __builtin_amdgcn_exp2f(x * 1.4426950408889634f); }
__device__ __forceinline__ float fast_log(float x) { return __builtin_amdgcn_logf(x) * 0.6931471805599453f; }
__device__ __forceinline__ float sigmoidf_(float x) { return __builtin_amdgcn_rcpf(1.0f + fast_exp(-x)); }
__device__ __forceinline__ float siluf_(float x) { return x * sigmoidf_(x); }
__device__ __forceinline__ float wave_sum(float v) {
#pragma unroll
    for (int o = 1; o < 64; o <<= 1) v += __shfl_xor(v, o);
    return v;
}
__device__ __forceinline__ float wave_max(float v) {
#pragma unroll
    for (int o = 1; o < 64; o <<= 1) v = fmaxf(v, __shfl_xor(v, o));
    return v;
}
__device__ __forceinline__ f32x4 mfma16(bf16x8 a, bf16x8 b, f32x4 c) { return __builtin_amdgcn_mfma_f32_16x16x32_bf16(a, b, c, 0, 0, 0); }
__device__ __forceinline__ bf16x8 cat8(u32x2 lo, u32x2 hi) { u32x4 w; w.x = lo.x; w.y = lo.y; w.z = hi.x; w.w = hi.y; return __builtin_bit_cast(bf16x8, w); }

__device__ __forceinline__ float row_rstd(const float* ss, int row) {
    const f32x4* sp = (const f32x4*)(ss + (size_t)row * 16);
    const f32x4 a = sp[0], b = sp[1], c = sp[2], d = sp[3];
    const f32x4 t = (a + b) + (c + d);
    return rsqrtf(((t[0] + t[1]) + (t[2] + t[3])) * (1.0f / 1024.0f) + EPS);
}
constexpr int RS_LDS_OFF = 131072;
template <class AccT> __device__ __forceinline__ void init_zero_rs(AccT& acc, const Unit& u, int wr, int wc, int fr, int fq, const float* ss, PG8_LAS float* rsb) {
#pragma unroll
    for (int a = 0; a < 2; ++a)
#pragma unroll
        for (int b = 0; b < 2; ++b)
#pragma unroll
            for (int m = 0; m < 4; ++m)
#pragma unroll
                for (int n = 0; n < 2; ++n) acc[a][b][m][n] = (f32x4){0.f, 0.f, 0.f, 0.f};
    const int t = (wr * 4 + wc) * 64 + fq * 16 + fr;
    if (t < 256) rsb[(u.idx & 1) * 256 + t] = row_rstd(ss, u.pm * 256 + t);
}
struct EpiSwiglu {
    static constexpr bool PERM = true, AFTER_DRAIN = false, HAS_INIT = false;
    bf16_t* H; const float* ss; PG8_LAS float* rsb;
    __device__ __forceinline__ void operator()(const f32x4 (&acc)[2][2][4][2], const Unit& u, int wr, int wc, int fr, int fq) const {
        const int row0 = u.pm * 256 + wr * 64 + fr, col0 = u.pn * 128 + wc * 32 + 8 * fq;
#pragma unroll
        for (int ai = 0; ai < 2; ++ai)
#pragma unroll
            for (int m = 0; m < 4; ++m) {
                const int row = row0 + ai * 128 + m * 16;
                const float rs = rsb[u.idx * 256 + ai * 128 + wr * 64 + m * 16 + fr];
                float h[8];
#pragma unroll
                for (int n = 0; n < 2; ++n)
#pragma unroll
                    for (int j = 0; j < 4; ++j) { const float g = acc[ai][0][m][n][j] * rs, up = acc[ai][1][m][n][j] * rs; h[n * 4 + j] = siluf_(g) * up; }
                u32x4 w; w.x = cvt_pk_bf16(h[0], h[1]); w.y = cvt_pk_bf16(h[2], h[3]); w.z = cvt_pk_bf16(h[4], h[5]); w.w = cvt_pk_bf16(h[6], h[7]);
                *(u32x4*)(H + (size_t)row * DFF + col0) = w;
            }
    }
};
struct EpiResid {
    static constexpr bool PERM = false, AFTER_DRAIN = false, HAS_INIT = true;
    float* X; bf16_t* XG; const float* g; float* ssn; float scale, iscale; int pm0;
    template <bool ADDX> __device__ __forceinline__ void rowgroup(const f32x4 (&a)[2][2], int row, int col0, const f32x4 (&gv)[2][2], int pn, int wc, int fq) const {
        float* xr = X + (size_t)row * 1024 + col0; bf16_t* gr = XG + (size_t)row * 1024 + col0;
        float part = 0.f;
#pragma unroll
        for (int bj = 0; bj < 2; ++bj)
#pragma unroll
            for (int n = 0; n < 2; ++n) {
                f32x4 xn = a[bj][n] * scale;
                if (ADDX) xn += *(const f32x4*)(xr + bj * 128 + n * 16);
                *(f32x4*)(xr + bj * 128 + n * 16) = xn;
                part += (xn[0] * xn[0] + xn[1] * xn[1]) + (xn[2] * xn[2] + xn[3] * xn[3]);
                *(u32x2*)(gr + bj * 128 + n * 16) = pack4(xn * gv[bj][n]);
            }
        part += __shfl_xor(part, 16); part += __shfl_xor(part, 32);
        if (fq == 0) ssn[(size_t)row * 16 + pn * 4 + wc] = part;
    }
    __device__ __forceinline__ void load_g(f32x4 (&gv)[2][2], int col0) const {
#pragma unroll
        for (int bj = 0; bj < 2; ++bj)
#pragma unroll
            for (int n = 0; n < 2; ++n) gv[bj][n] = *(const f32x4*)(g + col0 + bj * 128 + n * 16);
    }
    __device__ __forceinline__ void operator()(const f32x4 (&acc)[2][2][4][2], const Unit& u, int wr, int wc, int fr, int fq) const {
        const int row0 = (u.pm + pm0) * 256 + wr * 64 + fr, col0 = u.pn * 256 + wc * 32 + 4 * fq;
        f32x4 gv[2][2]; load_g(gv, col0);
#pragma unroll
        for (int ai = 0; ai < 2; ++ai)
#pragma unroll
            for (int m = 0; m < 4; ++m) {
                const f32x4 a[2][2] = {{acc[ai][0][m][0], acc[ai][0][m][1]}, {acc[ai][1][m][0], acc[ai][1][m][1]}};
                rowgroup<false>(a, row0 + ai * 128 + m * 16, col0, gv, u.pn, wc, fq);
            }
    }
    __device__ __forceinline__ void init(f32x4 (&acc)[2][2][4][2], const Unit& u, int wr, int wc, int fr, int fq) const {
        const int row0 = (u.pm + pm0) * 256 + wr * 64 + fr, col0 = u.pn * 256 + wc * 32 + 4 * fq;
#pragma unroll
        for (int ai = 0; ai < 2; ++ai)
#pragma unroll
            for (int m = 0; m < 4; ++m) {
                const float* xr = X + (size_t)(row0 + ai * 128 + m * 16) * 1024 + col0;
#pragma unroll
                for (int bj = 0; bj < 2; ++bj)
#pragma unroll
                    for (int n = 0; n < 2; ++n) acc[ai][bj][m][n] = *(const f32x4*)(xr + bj * 128 + n * 16) * iscale;
            }
    }
};
struct OneUnit { int pm, pn; bool have;
    __device__ __forceinline__ bool next(int i, Unit& u) const { if (i != 0 || !have) return false; u.pm = pm; u.pn = pn; u.idx = 0; return true; }
    __device__ __forceinline__ void a_ready(const Unit&) const {}
    __device__ __forceinline__ void done(const Unit&) const {} };
struct EpiSplit {
    static constexpr bool PERM = false, AFTER_DRAIN = true, HAS_INIT = false;
    EpiResid R; float* part; unsigned* cnt; int unit8, split, ns;
    __device__ __forceinline__ void fused(f32x4 (&acc)[2][2][4][2], const Unit& u, int wr, int wc, int fr, int fq, PG8_LAS unsigned char* lds, int wid, int lane) const {
        const int tid = wid * 64 + lane;
        f32x4* mine = (f32x4*)part + ((size_t)(split * 8 + unit8) * 32) * 512 + tid;
#pragma unroll
        for (int ai = 0; ai < 2; ++ai)
#pragma unroll
            for (int bj = 0; bj < 2; ++bj)
#pragma unroll
                for (int m = 0; m < 4; ++m)
#pragma unroll
                    for (int n = 0; n < 2; ++n) { *mine = acc[ai][bj][m][n]; mine += 512; asm volatile("" : "+v"(mine)); }
        asm volatile("s_waitcnt vmcnt(0)" ::: "memory");
        __syncthreads();
        PG8_LAS unsigned* flag = (PG8_LAS unsigned*)lds;
        if (tid == 0) {
            __builtin_amdgcn_fence(__ATOMIC_RELEASE, "agent"); asm volatile("s_waitcnt vmcnt(0)" ::: "memory");
            const unsigned old = __hip_atomic_fetch_add(cnt + unit8, 1u, __ATOMIC_RELAXED, __HIP_MEMORY_SCOPE_AGENT);
            if (old == (unsigned)(ns - 1)) { __builtin_amdgcn_fence(__ATOMIC_ACQUIRE, "agent"); asm volatile("s_waitcnt vmcnt(0)" ::: "memory"); }
            flag[0] = old;
        }
        __syncthreads();
        const bool last = (unsigned)__builtin_amdgcn_readfirstlane((int)flag[0]) == (unsigned)(ns - 1);
#ifndef NO_LAST
        if (last) {
            const int row0 = u.pm * 256 + wr * 64 + fr, col0 = u.pn * 256 + wc * 32 + 4 * fq;
            f32x4 gv[2][2]; R.load_g(gv, col0);
            const f32x4* base = (const f32x4*)part + ((size_t)unit8 * 32) * 512 + tid;
#pragma unroll 1
            for (int am = 0; am < 8; ++am) {
                const int ai = am >> 2, m = am & 3;
                f32x4 a[2][2];
#pragma unroll
                for (int bj = 0; bj < 2; ++bj)
#pragma unroll
                    for (int n = 0; n < 2; ++n) {
                        const f32x4* src = base + (size_t)((((ai * 2 + bj) * 4 + m) * 2 + n)) * 512;
                        f32x4 t = src[0];
#pragma unroll
                        for (int sp = 1; sp < 4; ++sp) t += src[(size_t)sp * 8 * 32 * 512];
                        a[bj][n] = t;
                    }
                R.rowgroup<true>(a, row0 + ai * 128 + m * 16, col0, gv, u.pn, wc, fq);
            }
        }
#endif
    }
};
struct EpiProj {
    static constexpr bool PERM = true, AFTER_DRAIN = false, HAS_INIT = false;
    bf16_t* P; int ld; const float* ss; int mode; const float* rope; float* side; PG8_LAS float* rsb;
    __device__ __forceinline__ void operator()(const f32x4 (&acc)[2][2][4][2], const Unit& u, int wr, int wc, int fr, int fq) const {
        const int row0 = u.pm * 256 + wr * 64 + fr, colb = u.pn * 256 + wc * 32 + 8 * fq;
#pragma unroll
        for (int ai = 0; ai < 2; ++ai)
#pragma unroll
            for (int m = 0; m < 4; ++m) {
                const int row = row0 + ai * 128 + m * 16;
                const float rs = rsb[u.idx * 256 + ai * 128 + wr * 64 + m * 16 + fr];
#pragma unroll
                for (int bj = 0; bj < 2; ++bj) {
                    const int col = colb + bj * 128;
                    f32x4 v0 = acc[ai][bj][m][0] * rs, v1 = acc[ai][bj][m][1] * rs;
                    if (mode == 0 && u.pn < 5 && (wc & 1) == 0) {
                        f32x4 p0, p1;
#pragma unroll
                        for (int j = 0; j < 4; ++j) { p0[j] = __shfl_xor(v0[j], 16); p1[j] = __shfl_xor(v1[j], 16); }
                        if (fq < 2) {
                            const int pidx = row < MP ? (row & 2047) : 2048 + ((row - MP) & 3);
                            const float* rp = rope + pidx * 16;
                            const f32x4 c0 = *(const f32x4*)rp, c1 = *(const f32x4*)(rp + 4), s0 = *(const f32x4*)(rp + 8), s1 = *(const f32x4*)(rp + 12);
                            const float sg = fq == 0 ? -1.f : 1.f;
                            v0 = v0 * c0 + p0 * s0 * sg; v1 = v1 * c1 + p1 * s1 * sg;
                        }
                    }
                    u32x4 w; w.x = cvt_pk_bf16(v0[0], v0[1]); w.y = cvt_pk_bf16(v0[2], v0[3]); w.z = cvt_pk_bf16(v1[0], v1[1]); w.w = cvt_pk_bf16(v1[2], v1[3]);
                    *(u32x4*)(P + (size_t)row * ld + col) = w;
                    if (mode == 1 && u.pn == 24 && bj == 0 && wc == 0) { float* sp = side + (size_t)row * 32 + 8 * fq; *(f32x4*)sp = v0; *(f32x4*)(sp + 4) = v1; }
                    if (mode == 2 && u.pn >= 4 && u.pn < 8) { float* sp = side + (size_t)row * 1024 + (col - 1024); *(f32x4*)sp = v0; *(f32x4*)(sp + 4) = v1; }
                }
            }
    }
};

__device__ __forceinline__ void convert_weights(const Params& p, unsigned char* shm, int grp, int wk, int nwk) {
    const int tid = otid();
    float* tile = (float*)shm;
    const int dlo = p.wg_desc[grp], dhi = p.wg_desc[grp + 1];
    __syncthreads();
    for (int it = p.wg_tile[grp] + wk; it < p.wg_tile[grp + 1]; it += nwk) {
        int d = dlo;
#pragma unroll 1
        while (d + 1 < dhi && it >= p.wd[d + 1].tile0) ++d;
        const float* src = p.wd[d].src; bf16_t* dst = p.wd[d].dst; const int K = p.wd[d].K, N = p.wd[d].N, mode = p.wd[d].mode, ntn = p.wd[d].Nrows >> 6;
        const int t = it - p.wd[d].tile0, k0 = (t / ntn) * 128, n0 = (t % ntn) * 64;
        {
            const int c = tid & 63, kr = tid >> 6; const int np = n0 + c; int col; bool ok = true;
            if (mode == 1) { const int pn = np >> 8, w = np & 255; col = (w >> 7) * DFF + pn * 128 + (w & 127); } else { col = np; ok = np < N; }
#pragma unroll
            for (int i = 0; i < 16; ++i) { const int k = kr + 8 * i; tile[k * 65 + c] = ok ? src[(size_t)(k0 + k) * N + col] : 0.f; }
        }
        __syncthreads();
#pragma unroll
        for (int i = 0; i < 2; ++i) {
            const int e = tid + 512 * i, nr = e >> 4, ch = e & 15;
            const float* sv = tile + (ch * 8) * 65 + nr;
            u32x4 o; o.x = cvt_pk_bf16(sv[0], sv[65]); o.y = cvt_pk_bf16(sv[2 * 65], sv[3 * 65]); o.z = cvt_pk_bf16(sv[4 * 65], sv[5 * 65]); o.w = cvt_pk_bf16(sv[6 * 65], sv[7 * 65]);
            *(u32x4*)(dst + (size_t)(n0 + nr) * K + k0 + ch * 8) = o;
        }
        __syncthreads();
    }
}

__device__ __forceinline__ void ph_prologue(const Params& p, unsigned char* shm) {
    const int tid = otid(), lane = tid & 63, wave = tid >> 6;
    const int gt = obid() * 512 + tid, ngt = gridDim.x * 512;
    float* SS = (float*)(p.ws + OFF_SS);
    if (gt < 96) ((unsigned*)(p.ws + OFF_CNT))[gt] = 0u;
    float* rope = (float*)(p.ws + OFF_ROPE);
    for (int i = gt; i < 2052 * 8; i += ngt) {
        const int pidx = i >> 3, k = i & 7; const int pos = pidx < 2048 ? pidx : 8192 + (pidx - 2048);
        const double ang = (double)pos * (double)p.inv_freq[k];
        double rev = ang * 0.15915494309189535; rev -= __builtin_rint(rev);
        const float a = (float)(rev * 6.283185307179586);
        rope[pidx * 16 + k] = __cosf(a); rope[pidx * 16 + 8 + k] = __sinf(a);
    }
    float* LB = (float*)(p.ws + OFF_LB);
    for (int i = gt; i < 1024; i += ngt) {
        const float l0 = p.hgrn_lb[i], l1 = p.hgrn_lb[1024 + i], l2 = p.hgrn_lb[2048 + i], l3 = p.hgrn_lb[3072 + i];
        const float mx = fmaxf(fmaxf(l0, l1), fmaxf(l2, l3));
        const float e0 = expf(l0 - mx), e1 = expf(l1 - mx), e2 = expf(l2 - mx), e3 = expf(l3 - mx);
        LB[i] = (e1 + e2) / (e0 + e1 + e2 + e3);
    }
    float* X = p.out; bf16_t* XG = (bf16_t*)(p.ws + OFF_XG);
    for (int r = obid() * 8 + wave; r < M_TOK; r += gridDim.x * 8) {
        const float* src = r < MP ? p.x_prompt + (size_t)r * 1024 : p.x_sample + (size_t)(r - MP) * 1024;
        float s = 0.f;
#pragma unroll
        for (int j = 0; j < 4; ++j) {
            const int c = lane * 4 + 256 * j;
            const f32x4 v = *(const f32x4*)(src + c), g = *(const f32x4*)(p.norm_ffn + c);
            *(f32x4*)(X + (size_t)r * 1024 + c) = v;
            s += (v[0] * v[0] + v[1] * v[1]) + (v[2] * v[2] + v[3] * v[3]);
            *(u32x2*)(XG + (size_t)r * 1024 + c) = pack4(v * g);
        }
        s = wave_sum(s);
        if (lane < 16) SS[(size_t)r * 16 + lane] = lane == 0 ? s : 0.f;
    }
    convert_weights(p, shm, 0, obid(), gridDim.x);
}

__device__ __forceinline__ void ph_final(const Params& p) {
    const int lane = otid() & 63, wave = otid() >> 6;
    const float* ss = (const float*)(p.ws + OFF_SS);
    for (int r = obid() * 8 + wave; r < M_TOK; r += gridDim.x * 8) {
        const float rs = row_rstd(ss, r);
#pragma unroll
        for (int j = 0; j < 4; ++j) {
            const int c = lane * 4 + 256 * j;
            float* xp = p.out + (size_t)r * 1024 + c;
            *(f32x4*)xp = *(const f32x4*)xp * rs * *(const f32x4*)(p.final_norm + c);
        }
    }
}

__device__ __forceinline__ void swa_prompt_item(const Params& p, unsigned char* shm, int j, int item) {
    const int tid = otid(), lane = tid & 63, wave = tid >> 6, fr = lane & 15, fq = lane >> 4;
    const int n = item & 15, kvh = (item >> 4) & 3, b = item >> 6;
    const bf16_t* P = (const bf16_t*)(p.ws + OFF_PROJ);
    bf16_t* Ob = (bf16_t*)(p.ws + OFF_O);
    bf16_t* Ks = (bf16_t*)shm;
    bf16_t* Vt = (bf16_t*)(shm + 36864);
    const size_t rowbase = (size_t)b * 2048;
    const int g = wave >> 1, qh = wave & 1, h = kvh * 4 + g;
    bf16x8 qfr[4][2];
    {
        u32x4 kvr[4], vvr[4];
#pragma unroll
        for (int k = 0; k < 4; ++k) {
            const int e = tid + 512 * k, key = e >> 3, ch = e & 7; const int pos = (n - 1) * 128 + key;
            kvr[k] = (u32x4){0u, 0u, 0u, 0u}; vvr[k] = (u32x4){0u, 0u, 0u, 0u};
            if (pos >= 0) { const bf16_t* src = P + (rowbase + pos) * 1536; kvr[k] = *(const u32x4*)(src + 1024 + kvh * 64 + ch * 8); vvr[k] = *(const u32x4*)(src + 1280 + kvh * 64 + ch * 8); }
        }
#pragma unroll
        for (int ti = 0; ti < 4; ++ti) {
            const bf16_t* qsrc = P + (rowbase + n * 128 + qh * 64 + ti * 16 + fr) * 1536 + h * 64 + fq * 8;
            qfr[ti][0] = *(const bf16x8*)qsrc; qfr[ti][1] = *(const bf16x8*)(qsrc + 32);
        }
#pragma unroll
        for (int k = 0; k < 4; ++k) {
            const int e = tid + 512 * k, key = e >> 3, ch = e & 7;
            const u32x4 kv = kvr[k], vv = vvr[k];
            *(u32x4*)(Ks + key * 72 + ch * 8) = kv;
#pragma unroll
            for (int q = 0; q < 4; ++q) { Vt[(ch * 8 + 2 * q) * 264 + key] = (bf16_t)(vv[q] & 0xffffu); Vt[(ch * 8 + 2 * q + 1) * 264 + key] = (bf16_t)(vv[q] >> 16); }
            if (n == 15 && key >= 128) {
                const size_t o = ((size_t)((j * 8 + b) * 128 + (key - 128))) * 256 + kvh * 64 + ch * 8;
                float* ok = p.out + OUT_PK + o; float* ov = p.out + OUT_PV + o;
#pragma unroll
                for (int q = 0; q < 4; ++q) { ok[2 * q] = bflo(kv[q]); ok[2 * q + 1] = bfhi(kv[q]); ov[2 * q] = bflo(vv[q]); ov[2 * q + 1] = bfhi(vv[q]); }
            }
        }
    }
    __syncthreads();
    const float sink = p.swa_sinks[j * 16 + h];
#pragma unroll
    for (int ti = 0; ti < 4; ++ti) {
        const int q0 = qh * 64 + ti * 16, T0 = q0 >> 4;
        const bf16x8 qf0 = qfr[ti][0], qf1 = qfr[ti][1];
        f32x4 s[9];
#pragma unroll
        for (int kt = 0; kt < 9; ++kt) {
            const bf16_t* kp = Ks + ((T0 + kt) * 16 + fr) * 72 + fq * 8;
            f32x4 a = {0.f, 0.f, 0.f, 0.f};
            a = mfma16(*(const bf16x8*)kp, qf0, a); a = mfma16(*(const bf16x8*)(kp + 32), qf1, a);
            s[kt] = a;
        }
        const int ql = q0 + fr; float mx = -1e30f;
#pragma unroll
        for (int kt = 0; kt < 9; ++kt)
#pragma unroll
            for (int jj = 0; jj < 4; ++jj) {
                const int kl = (T0 + kt) * 16 + 4 * fq + jj;
                const bool valid = (kl > ql) && (kl <= ql + 128) && (n > 0 || kl >= 128);
                const float v = valid ? s[kt][jj] * 0.125f : -1e30f; s[kt][jj] = v; mx = fmaxf(mx, v);
            }
        mx = fmaxf(mx, __shfl_xor(mx, 16)); mx = fmaxf(mx, __shfl_xor(mx, 32)); mx = fmaxf(mx, sink);
        float l = 0.f;
#pragma unroll
        for (int kt = 0; kt < 9; ++kt)
#pragma unroll
            for (int jj = 0; jj < 4; ++jj) { const float e = fast_exp(s[kt][jj] - mx); s[kt][jj] = e; l += e; }
        l += __shfl_xor(l, 16); l += __shfl_xor(l, 32); l += fast_exp(sink - mx);
        bf16x8 pf[5];
#pragma unroll
        for (int u = 0; u < 4; ++u) pf[u] = cat8(pack4(s[2 * u]), pack4(s[2 * u + 1]));
        { const u32x2 z = {0u, 0u}; pf[4] = cat8(pack4(s[8]), z); }
        f32x4 o[4];
#pragma unroll
        for (int td = 0; td < 4; ++td) {
            f32x4 a = {0.f, 0.f, 0.f, 0.f};
#pragma unroll
            for (int u = 0; u < 5; ++u) {
                const bf16_t* vp = Vt + (td * 16 + fr) * 264 + (T0 + 2 * u) * 16 + 4 * fq;
                const u32x2 lo = *(const u32x2*)vp; u32x2 hi = {0u, 0u};
                if (u < 4) hi = *(const u32x2*)(vp + 16);
                a = mfma16(cat8(lo, hi), pf[u], a);
            }
            o[td] = a;
        }
        const float inv = 1.0f / l;
        bf16_t* op = Ob + (rowbase + n * 128 + q0 + fr) * 1024 + h * 64 + 4 * fq;
#pragma unroll
        for (int td = 0; td < 4; ++td) *(u32x2*)(op + td * 16) = pack4(o[td] * inv);
    }
    __syncthreads();
}

__device__ __forceinline__ void swa_sample_item(const Params& p, unsigned char* shm, int j, int item) {
    const int tid = otid(), lane = tid & 63, wave = tid >> 6, fr = lane & 15, fq = lane >> 4;
    const int kvh = item & 3, b = item >> 2;
    const bf16_t* P = (const bf16_t*)(p.ws + OFF_PROJ);
    bf16_t* Ob = (bf16_t*)(p.ws + OFF_O);
    bf16_t* Ks = (bf16_t*)shm;
    bf16_t* Vt = Ks + 144 * 72;
    const size_t cb = ((size_t)(j * 128 + b) * 128) * 256 + kvh * 64;
    const float* ck = p.cache_k + cb; const float* cv = p.cache_v + cb;
    float* ok = p.out + OUT_SK + cb; float* ov = p.out + OUT_SV + cb;
    const int tq = fr & 3, gq = fr >> 2;
    bf16x8 qf0, qf1;
    { const bf16_t* qsrc = P + (size_t)(MP + b * 4 + tq) * 1536 + (kvh * 4 + gq) * 64 + fq * 8; qf0 = *(const bf16x8*)qsrc; qf1 = *(const bf16x8*)(qsrc + 32); }
    for (int e0 = tid; e0 < 148 * 64; e0 += 2048) {
        float kx[4], vx[4];
#pragma unroll
        for (int k = 0; k < 4; ++k) {
            const int e = e0 + 512 * k, row = e >> 6, d = e & 63; kx[k] = 0.f; vx[k] = 0.f;
            if (row < 128) { kx[k] = ck[row * 256 + d]; vx[k] = cv[row * 256 + d]; }
            else if (row < 132) { const bf16_t* src = P + (size_t)(MP + b * 4 + row - 128) * 1536; kx[k] = bf2f(src[1024 + kvh * 64 + d]); vx[k] = bf2f(src[1280 + kvh * 64 + d]); }
        }
#pragma unroll
        for (int k = 0; k < 4; ++k) {
            const int e = e0 + 512 * k, row = e >> 6, d = e & 63;
            if (row < 148) {
                if (row < 144) Ks[row * 72 + d] = f2bf(kx[k]);
                Vt[d * 148 + row] = f2bf(vx[k]);
                if (row >= 4 && row < 132) { ok[(row - 4) * 256 + d] = kx[k]; ov[(row - 4) * 256 + d] = vx[k]; }
            }
        }
    }
    __syncthreads();
    if (wave == 0) {
        const float sink = p.swa_sinks[j * 16 + kvh * 4 + gq];
        f32x4 s[9];
#pragma unroll
        for (int kt = 0; kt < 9; ++kt) {
            const bf16_t* kp = Ks + (kt * 16 + fr) * 72 + fq * 8;
            f32x4 a = {0.f, 0.f, 0.f, 0.f};
            a = mfma16(*(const bf16x8*)kp, qf0, a); a = mfma16(*(const bf16x8*)(kp + 32), qf1, a);
            s[kt] = a;
        }
        float mx = -1e30f;
#pragma unroll
        for (int kt = 0; kt < 9; ++kt)
#pragma unroll
            for (int jj = 0; jj < 4; ++jj) {
                const int kl = kt * 16 + 4 * fq + jj;
                const bool valid = kl >= tq + 1 && kl <= tq + 128;
                const float v = valid ? s[kt][jj] * 0.125f : -1e30f; s[kt][jj] = v; mx = fmaxf(mx, v);
            }
        mx = fmaxf(mx, __shfl_xor(mx, 16)); mx = fmaxf(mx, __shfl_xor(mx, 32)); mx = fmaxf(mx, sink);
        float l = 0.f;
#pragma unroll
        for (int kt = 0; kt < 9; ++kt)
#pragma unroll
            for (int jj = 0; jj < 4; ++jj) { const float e = fast_exp(s[kt][jj] - mx); s[kt][jj] = e; l += e; }
        l += __shfl_xor(l, 16); l += __shfl_xor(l, 32); l += fast_exp(sink - mx);
        bf16x8 pf[5];
#pragma unroll
        for (int u = 0; u < 4; ++u) pf[u] = cat8(pack4(s[2 * u]), pack4(s[2 * u + 1]));
        { const u32x2 z = {0u, 0u}; pf[4] = cat8(pack4(s[8]), z); }
        const float inv = 1.0f / l;
        bf16_t* op = Ob + (size_t)(MP + b * 4 + tq) * 1024 + (kvh * 4 + gq) * 64 + 4 * fq;
#pragma unroll
        for (int td = 0; td < 4; ++td) {
            f32x4 a = {0.f, 0.f, 0.f, 0.f};
#pragma unroll
            for (int u = 0; u < 5; ++u) {
                const bf16_t* vp = Vt + (td * 16 + fr) * 148 + (2 * u) * 16 + 4 * fq;
                const u32x2 lo = *(const u32x2*)vp; u32x2 hi = {0u, 0u};
                if (u < 4) hi = *(const u32x2*)(vp + 16);
                a = mfma16(cat8(lo, hi), pf[u], a);
            }
            *(u32x2*)(op + td * 16) = pack4(a * inv);
        }
    }
    __syncthreads();
}

__device__ __forceinline__ void gdn_g1_unit(const Params& p, unsigned char* shm, int unit) {
    const int tid = otid(), lane = tid & 63, wave = tid >> 6, fr = lane & 15, fq = lane >> 4;
    const int c = unit & 31, vh = (unit >> 5) & 15, b = unit >> 9, hq = vh >> 1;
    const int R0 = b * 2048 + c * 64;
    const bf16_t* P = (const bf16_t*)(p.ws + OFF_PROJ);
    const float* BA = (const float*)(p.ws + OFF_BA);
    bf16_t* qn = (bf16_t*)shm;
    bf16_t* kn = qn + 64 * 136;
    bf16_t* kbgT = kn + 64 * 136;
    bf16_t* vbT = kbgT + 128 * 72;
    float* Af = (float*)(vbT + 128 * 72);
    bf16_t* Tb = (bf16_t*)(Af + 64 * 68);
    float* gc = (float*)(Tb + 64 * 72);
    float* bt = gc + 64;
    float* GCUM = (float*)(p.ws + OFF_GCUM);
    {
        const int un = unit + (int)gridDim.x;
        if (un < 4096 && tid < 466) {
            const int cn = un & 31, vhn = (un >> 5) & 15, bn = un >> 9, hqn = vhn >> 1, Rn = bn * 2048 + cn * 64;
            const char* a = nullptr;
            if (tid < 402) { const int r = tid / 6, sgl = tid - r * 6, seg = sgl >> 1, row = Rn - 3 + r;
                if (row >= bn * 2048) a = (const char*)(P + (size_t)row * 6400 + (seg == 0 ? hqn * 128 : (seg == 1 ? 1024 + hqn * 128 : 2048 + vhn * 128)) + (sgl & 1) * 64); }
            else a = (const char*)(BA + (size_t)(Rn + tid - 402) * 32);
            if (a) (void)*(const volatile float*)a;
        }
    }
    if (wave == 0) {
        const int r = R0 + lane;
        const float a = BA[(size_t)r * 32 + 16 + vh] + p.gdn_dt_bias[vh];
        const float sp = a > 20.f ? a : log1pf(expf(a));
        const float g = -expf(p.gdn_a_log[vh]) * sp;
        const float be = 1.0f / (1.0f + fast_exp(-BA[(size_t)r * 32 + vh]));
        float cs = g;
#pragma unroll
        for (int o = 1; o < 64; o <<= 1) { const float t = __shfl_up(cs, o); if (lane >= o) cs += t; }
        gc[lane] = cs; bt[lane] = be; GCUM[(size_t)unit * 64 + lane] = cs;
    }
    __syncthreads();
    {
        const int i = tid >> 3, cb = tid & 7, t = c * 64 + i;
        const float be = bt[i], eg = fast_exp(gc[i]);
        const int uq = (b * 8 + hq) * 32 + c;
#pragma unroll
        for (int op = 0; op < 3; ++op) {
            const int col = op == 0 ? hq * 128 + cb * 16 : (op == 1 ? 1024 + hq * 128 + cb * 16 : 2048 + vh * 128 + cb * 16);
            float acc[16];
#pragma unroll
            for (int e = 0; e < 16; ++e) acc[e] = 0.f;
#pragma unroll
            for (int jj = 0; jj < 4; ++jj) {
                const int tt = t - 3 + jj;
                if (tt >= 0) {
                    const bf16_t* src = P + (size_t)(b * 2048 + tt) * 6400 + col;
                    const u32x4 xa = *(const u32x4*)src, xb = *(const u32x4*)(src + 8);
                    const float* w = p.gdn_conv_w + jj * 4096 + col;
                    float x[16];
#pragma unroll
                    for (int q = 0; q < 4; ++q) { x[2 * q] = bflo(xa[q]); x[2 * q + 1] = bfhi(xa[q]); x[8 + 2 * q] = bflo(xb[q]); x[8 + 2 * q + 1] = bfhi(xb[q]); }
#pragma unroll
                    for (int q = 0; q < 4; ++q) { const f32x4 wv = *(const f32x4*)(w + 4 * q);
#pragma unroll
                        for (int e = 0; e < 4; ++e) acc[4 * q + e] += x[4 * q + e] * wv[e]; }
                    if (jj == 3 && c == 31 && i >= 61 && (op == 2 || (vh & 1) == 0)) {
                        float* pc = p.out + OUT_PC + (size_t)(b * 3 + (i - 61)) * 4096 + col;
#pragma unroll
                        for (int q = 0; q < 4; ++q) { f32x4 o; o[0] = x[4 * q]; o[1] = x[4 * q + 1]; o[2] = x[4 * q + 2]; o[3] = x[4 * q + 3]; *(f32x4*)(pc + 4 * q) = o; }
                    }
                }
            }
#pragma unroll
            for (int e = 0; e < 16; ++e) acc[e] = siluf_(acc[e]);
            if (op < 2) {
                float ss = 0.f;
#pragma unroll
                for (int e = 0; e < 16; ++e) ss += acc[e] * acc[e];
                ss += __shfl_xor(ss, 1); ss += __shfl_xor(ss, 2); ss += __shfl_xor(ss, 4);
                float rn = rsqrtf(ss + 1e-6f); if (op == 0) rn *= 0.08838834764831845f;
#pragma unroll
                for (int e = 0; e < 16; ++e) acc[e] *= rn;
                u32x4 w0, w1;
#pragma unroll
                for (int q = 0; q < 4; ++q) { w0[q] = cvt_pk_bf16(acc[2 * q], acc[2 * q + 1]); w1[q] = cvt_pk_bf16(acc[8 + 2 * q], acc[8 + 2 * q + 1]); }
                bf16_t* ld = (op == 0 ? qn : kn) + i * 136 + cb * 16;
                *(u32x4*)ld = w0; *(u32x4*)(ld + 8) = w1;
                if ((vh & 1) == 0) {
                    bf16_t* gd = (bf16_t*)(p.ws + (op == 0 ? OFF_QN : OFF_KN)) + (size_t)uq * 8192 + i * 128 + cb * 16;
                    *(u32x4*)gd = w0; *(u32x4*)(gd + 8) = w1;
                }
                if (op == 1) {
                    const float f = be * eg;
#pragma unroll
                    for (int e = 0; e < 16; ++e) kbgT[(cb * 16 + e) * 72 + i] = f2bf(acc[e] * f);
                }
            } else {
#pragma unroll
                for (int e = 0; e < 16; ++e) vbT[(cb * 16 + e) * 72 + i] = f2bf(acc[e] * be);
            }
        }
    }
    __syncthreads();
    {
        const int which = wave >> 2, ti = wave & 3; const bf16_t* bsrc = which ? qn : kn;
        bf16x8 bfr[4];
#pragma unroll
        for (int ks = 0; ks < 4; ++ks) bfr[ks] = *(const bf16x8*)(bsrc + (ti * 16 + fr) * 136 + ks * 32 + fq * 8);
        const int i = ti * 16 + fr; const float gi = gc[i], bi = bt[i];
        bf16_t* ATT = (bf16_t*)(p.ws + OFF_ATT) + (size_t)unit * 4096;
#pragma unroll
        for (int tj = 0; tj < 4; ++tj) {
            f32x4 a = {0.f, 0.f, 0.f, 0.f};
            if (tj <= ti) {
#pragma unroll
                for (int ks = 0; ks < 4; ++ks) a = mfma16(*(const bf16x8*)(kn + (tj * 16 + fr) * 136 + ks * 32 + fq * 8), bfr[ks], a);
            }
            f32x4 r;
#pragma unroll
            for (int jj = 0; jj < 4; ++jj) {
                const int jx = tj * 16 + 4 * fq + jj;
                const float dec = fast_exp(fminf(gi - gc[jx], 0.f));
                r[jj] = which ? (jx <= i ? a[jj] * dec : 0.f) : (jx < i ? a[jj] * dec * bi : 0.f);
            }
            if (which == 0) *(f32x4*)(Af + i * 68 + tj * 16 + 4 * fq) = r;
            else *(u32x2*)(ATT + i * 64 + tj * 16 + 4 * fq) = pack4(r);
        }
    }
    __syncthreads();
    if (wave == 0) {
        float ar[64];
#pragma unroll
        for (int i = 0; i < 64; ++i) ar[i] = Af[i * 68 + lane];
        float t[64];
#pragma unroll
        for (int i = 0; i < 64; ++i) {
            float a0 = (i == lane) ? 1.f : 0.f, a1 = 0.f, a2 = 0.f, a3 = 0.f;
#pragma unroll
            for (int j = 0; j < i; ++j) {
                const float sv = __int_as_float(__builtin_amdgcn_readlane(__float_as_int(ar[i]), j));
                if ((j & 3) == 0) a0 -= sv * t[j]; else if ((j & 3) == 1) a1 -= sv * t[j]; else if ((j & 3) == 2) a2 -= sv * t[j]; else a3 -= sv * t[j];
            }
            t[i] = (a0 + a1) + (a2 + a3);
        }
#pragma unroll
        for (int i = 0; i < 64; ++i) Tb[i * 72 + lane] = f2bf(t[i]);
    }
    __syncthreads();
    {
        const int td = wave;
        const bf16x8 a0 = *(const bf16x8*)(kbgT + (td * 16 + fr) * 72 + fq * 8), a1 = *(const bf16x8*)(kbgT + (td * 16 + fr) * 72 + 32 + fq * 8);
        const bf16x8 v0 = *(const bf16x8*)(vbT + (td * 16 + fr) * 72 + fq * 8), v1 = *(const bf16x8*)(vbT + (td * 16 + fr) * 72 + 32 + fq * 8);
        bf16_t* W = (bf16_t*)(p.ws + OFF_GW) + (size_t)unit * 8192; bf16_t* UT = (bf16_t*)(p.ws + OFF_GUT) + (size_t)unit * 8192;
#pragma unroll
        for (int ti = 0; ti < 4; ++ti) {
            const bf16x8 t0 = *(const bf16x8*)(Tb + (ti * 16 + fr) * 72 + fq * 8), t1 = *(const bf16x8*)(Tb + (ti * 16 + fr) * 72 + 32 + fq * 8);
            f32x4 w = {0.f, 0.f, 0.f, 0.f}; w = mfma16(a0, t0, w); w = mfma16(a1, t1, w);
            *(u32x2*)(W + (ti * 16 + fr) * 128 + td * 16 + 4 * fq) = pack4(w);
            f32x4 uu = {0.f, 0.f, 0.f, 0.f}; uu = mfma16(t0, v0, uu); uu = mfma16(t1, v1, uu);
            *(u32x2*)(UT + (td * 16 + fr) * 64 + ti * 16 + 4 * fq) = pack4(uu);
        }
    }
    __syncthreads();
}

__device__ __forceinline__ void gdn_g1_pair(const Params& p, unsigned char* shm, int pair) {
    const int tid = otid(), lane = tid & 63, wave = tid >> 6, fr = lane & 15, fq = lane >> 4;
    const int c = pair & 31, hq = (pair >> 5) & 7, b = pair >> 8;
    const int R0 = b * 2048 + c * 64;
    const bf16_t* P = (const bf16_t*)(p.ws + OFF_PROJ);
    const float* BA = (const float*)(p.ws + OFF_BA);
    bf16_t* qn = (bf16_t*)shm;
    bf16_t* kn = qn + 64 * 136;
    bf16_t* kbgT = kn + 64 * 136;
    bf16_t* vbT = kbgT + 2 * 128 * 72;
    float* Af = (float*)(vbT + 2 * 128 * 72);
    float* gc = Af + 2 * 64 * 68;
    float* bt = gc + 128;
    float* GCUM = (float*)(p.ws + OFF_GCUM);
    float pf0 = 0.f, pf1 = 0.f;
    {
        const int pn = pair + (int)gridDim.x;
        if (pn < 2048) {
            const int cn = pn & 31, hqn = (pn >> 5) & 7, bn = pn >> 8, Rn = bn * 2048 + cn * 64;
#pragma unroll
            for (int kk2 = 0; kk2 < 2; ++kk2) {
                const int k = tid + 512 * kk2;
                const char* a = nullptr;
                if (k < 536) { const int r = k >> 3, sg = k & 7, row = Rn - 3 + r;
                    if (row >= bn * 2048) a = (const char*)(P + (size_t)row * 6400 + (sg < 2 ? hqn * 128 + sg * 64 : (sg < 4 ? 1024 + hqn * 128 + (sg - 2) * 64 : 2048 + hqn * 256 + (sg - 4) * 64))); }
                else if (k < 600) a = (const char*)(BA + (size_t)(Rn + k - 536) * 32);
                if (a) { const float v = *(const volatile float*)a; if (kk2 == 0) pf0 = v; else pf1 = v; }
            }
        }
    }
    if (wave < 2) {
        const int vh = 2 * hq + wave, r = R0 + lane, unit = (b * 16 + vh) * 32 + c;
        const float a = BA[(size_t)r * 32 + 16 + vh] + p.gdn_dt_bias[vh];
        const float sp = a > 20.f ? a : log1pf(expf(a));
        const float g = -expf(p.gdn_a_log[vh]) * sp;
        const float be = 1.0f / (1.0f + fast_exp(-BA[(size_t)r * 32 + vh]));
        float cs = g;
#pragma unroll
        for (int o = 1; o < 64; o <<= 1) { const float t = __shfl_up(cs, o); if (lane >= o) cs += t; }
        gc[wave * 64 + lane] = cs; bt[wave * 64 + lane] = be; GCUM[(size_t)unit * 64 + lane] = cs;
    }
    __syncthreads();
    {
        const int rg = wave, i0 = rg * 8, t0 = c * 64 + i0;
        const int uq = (b * 8 + hq) * 32 + c;
        float f0[8], f1[8], e0[8], e1[8];
#pragma unroll
        for (int e = 0; e < 8; ++e) { e0[e] = bt[i0 + e]; e1[e] = bt[64 + i0 + e]; f0[e] = e0[e] * fast_exp(gc[i0 + e]); f1[e] = e1[e] * fast_exp(gc[64 + i0 + e]); }
#pragma unroll
        for (int op = 0; op < 4; ++op) {
            const int col = (op == 0 ? hq * 128 : (op == 1 ? 1024 + hq * 128 : 2048 + (2 * hq + (op - 2)) * 128)) + 2 * lane;
            unsigned xr[11];
#pragma unroll
            for (int rr = 0; rr < 11; ++rr) { const int tt = t0 - 3 + rr; xr[rr] = tt >= 0 ? *(const unsigned*)(P + (size_t)(b * 2048 + tt) * 6400 + col) : 0u; }
            f32x2 wv[4];
#pragma unroll
            for (int jj = 0; jj < 4; ++jj) wv[jj] = *(const f32x2*)(p.gdn_conv_w + jj * 4096 + col);
            if (c == 31 && rg == 7) {
#pragma unroll
                for (int e = 5; e < 8; ++e) { f32x2 o; o.x = bflo(xr[e + 3]); o.y = bfhi(xr[e + 3]); *(f32x2*)(p.out + OUT_PC + (size_t)(b * 3 + (e - 5)) * 4096 + col) = o; }
            }
            float a0[8], a1[8];
#pragma unroll
            for (int e = 0; e < 8; ++e) {
                float s0 = 0.f, s1 = 0.f;
#pragma unroll
                for (int jj = 0; jj < 4; ++jj) { s0 += bflo(xr[e + jj]) * wv[jj].x; s1 += bfhi(xr[e + jj]) * wv[jj].y; }
                a0[e] = siluf_(s0); a1[e] = siluf_(s1);
            }
            if (op < 2) {
#pragma unroll
                for (int e = 0; e < 8; ++e) {
                    float rn = rsqrtf(wave_sum(a0[e] * a0[e] + a1[e] * a1[e]) + 1e-6f); if (op == 0) rn *= 0.08838834764831845f;
                    a0[e] *= rn; a1[e] *= rn;
                    const unsigned w = cvt_pk_bf16(a0[e], a1[e]);
                    *(unsigned*)((op == 0 ? qn : kn) + (i0 + e) * 136 + 2 * lane) = w;
                    *(unsigned*)((bf16_t*)(p.ws + (op == 0 ? OFF_QN : OFF_KN)) + (size_t)uq * 8192 + (i0 + e) * 128 + 2 * lane) = w;
                }
                if (op == 1) {
                    u32x4 k00, k01, k10, k11;
#pragma unroll
                    for (int q = 0; q < 4; ++q) {
                        k00[q] = cvt_pk_bf16(a0[2 * q] * f0[2 * q], a0[2 * q + 1] * f0[2 * q + 1]); k01[q] = cvt_pk_bf16(a1[2 * q] * f0[2 * q], a1[2 * q + 1] * f0[2 * q + 1]);
                        k10[q] = cvt_pk_bf16(a0[2 * q] * f1[2 * q], a0[2 * q + 1] * f1[2 * q + 1]); k11[q] = cvt_pk_bf16(a1[2 * q] * f1[2 * q], a1[2 * q + 1] * f1[2 * q + 1]);
                    }
                    *(u32x4*)(kbgT + (2 * lane) * 72 + i0) = k00; *(u32x4*)(kbgT + (2 * lane + 1) * 72 + i0) = k01;
                    *(u32x4*)(kbgT + 128 * 72 + (2 * lane) * 72 + i0) = k10; *(u32x4*)(kbgT + 128 * 72 + (2 * lane + 1) * 72 + i0) = k11;
                }
            } else {
                bf16_t* vd = vbT + (op - 2) * 128 * 72;
                u32x4 v0w, v1w;
#pragma unroll
                for (int q = 0; q < 4; ++q) {
                    const float b0 = op == 2 ? e0[2 * q] : e1[2 * q], b1 = op == 2 ? e0[2 * q + 1] : e1[2 * q + 1];
                    v0w[q] = cvt_pk_bf16(a0[2 * q] * b0, a0[2 * q + 1] * b1); v1w[q] = cvt_pk_bf16(a1[2 * q] * b0, a1[2 * q + 1] * b1);
                }
                *(u32x4*)(vd + (2 * lane) * 72 + i0) = v0w; *(u32x4*)(vd + (2 * lane + 1) * 72 + i0) = v1w;
            }
        }
    }
    __syncthreads();
    {
        const int which = wave >> 2, ti = wave & 3; const bf16_t* bsrc = which ? qn : kn;
        bf16x8 bfr[4];
#pragma unroll
        for (int ks = 0; ks < 4; ++ks) bfr[ks] = *(const bf16x8*)(bsrc + (ti * 16 + fr) * 136 + ks * 32 + fq * 8);
        const int i = ti * 16 + fr;
        const float gi0 = gc[i], gi1 = gc[64 + i], bi0 = bt[i], bi1 = bt[64 + i];
        bf16_t* ATT0 = (bf16_t*)(p.ws + OFF_ATT) + (size_t)((b * 16 + 2 * hq) * 32 + c) * 4096;
        bf16_t* ATT1 = ATT0 + (size_t)32 * 4096;
#pragma unroll
        for (int tj = 0; tj < 4; ++tj) {
            f32x4 a = {0.f, 0.f, 0.f, 0.f};
            if (tj <= ti) {
#pragma unroll
                for (int ks = 0; ks < 4; ++ks) a = mfma16(*(const bf16x8*)(kn + (tj * 16 + fr) * 136 + ks * 32 + fq * 8), bfr[ks], a);
            }
            f32x4 r0, r1;
#pragma unroll
            for (int jj = 0; jj < 4; ++jj) {
                const int jx = tj * 16 + 4 * fq + jj;
                const float d0 = fast_exp(fminf(gi0 - gc[jx], 0.f)), d1 = fast_exp(fminf(gi1 - gc[64 + jx], 0.f));
                r0[jj] = which ? (jx <= i ? a[jj] * d0 : 0.f) : (jx < i ? a[jj] * d0 * bi0 : 0.f);
                r1[jj] = which ? (jx <= i ? a[jj] * d1 : 0.f) : (jx < i ? a[jj] * d1 * bi1 : 0.f);
            }
            if (which == 0) { *(f32x4*)(Af + i * 68 + tj * 16 + 4 * fq) = r0; *(f32x4*)(Af + 64 * 68 + i * 68 + tj * 16 + 4 * fq) = r1; }
            else { *(u32x2*)(ATT0 + i * 64 + tj * 16 + 4 * fq) = pack4(r0); *(u32x2*)(ATT1 + i * 64 + tj * 16 + 4 * fq) = pack4(r1); }
        }
    }
    __syncthreads();
    {
        bf16_t* scr = qn;
        const int hh = (wave >> 1) & 1, blk = wave & 1, l32 = lane & 31;
        bf16_t* T11T = scr + hh * 3 * 1280; bf16_t* T22R = T11T + 1280; bf16_t* YT = T22R + 1280;
        bf16_t* Tbh = (bf16_t*)(Af + hh * 64 * 68);
        bf16x8 a21f[2];
        float t[32];
        if (wave < 4) {
            const float* Ah = Af + hh * 64 * 68;
            float ar[32];
#pragma unroll
            for (int i = 0; i < 32; ++i) ar[i] = Ah[(32 * blk + i) * 68 + 32 * blk + l32];
            if (blk == 0) {
#pragma unroll
                for (int ti = 0; ti < 2; ++ti) { const float* ap = Ah + (32 + 16 * ti + fr) * 68 + 8 * fq; a21f[ti] = cat8(pack4(*(const f32x4*)ap), pack4(*(const f32x4*)(ap + 4))); }
            }
            asm volatile("s_waitcnt lgkmcnt(0)" ::: "memory");
#pragma unroll
            for (int i = 0; i < 32; ++i) {
                float a0 = (i == l32) ? 1.f : 0.f, a1 = 0.f, a2 = 0.f, a3 = 0.f;
#pragma unroll
                for (int j = 0; j < i; ++j) {
                    const float sv = __int_as_float(__builtin_amdgcn_readlane(__float_as_int(ar[i]), j));
                    if ((j & 3) == 0) a0 -= sv * t[j]; else if ((j & 3) == 1) a1 -= sv * t[j]; else if ((j & 3) == 2) a2 -= sv * t[j]; else a3 -= sv * t[j];
                }
                t[i] = (a0 + a1) + (a2 + a3);
            }
            if (lane < 32) {
                if (blk == 0) {
#pragma unroll
                    for (int q = 0; q < 4; ++q) { u32x4 w; w.x = cvt_pk_bf16(t[8 * q], t[8 * q + 1]); w.y = cvt_pk_bf16(t[8 * q + 2], t[8 * q + 3]); w.z = cvt_pk_bf16(t[8 * q + 4], t[8 * q + 5]); w.w = cvt_pk_bf16(t[8 * q + 6], t[8 * q + 7]); *(u32x4*)(T11T + lane * 40 + q * 8) = w; }
                } else {
#pragma unroll
                    for (int i = 0; i < 32; ++i) T22R[i * 40 + lane] = f2bf(t[i]);
                }
            }
        }
        __syncthreads();
        if (wave < 4) {
            if (lane < 32) {
#pragma unroll
                for (int i = 0; i < 32; ++i) Tbh[(32 * blk + i) * 72 + 32 * blk + lane] = f2bf(t[i]);
                if (blk == 0) {
#pragma unroll
                    for (int i = 0; i < 32; ++i) Tbh[i * 72 + 32 + lane] = (bf16_t)0;
                }
            }
            if (blk == 0) {
#pragma unroll
                for (int tj = 0; tj < 2; ++tj) {
                    const bf16x8 bfr = *(const bf16x8*)(T11T + (16 * tj + fr) * 40 + 8 * fq);
#pragma unroll
                    for (int ti = 0; ti < 2; ++ti) {
                        f32x4 y = {0.f, 0.f, 0.f, 0.f}; y = mfma16(a21f[ti], bfr, y);
                        *(u32x2*)(YT + (16 * tj + fr) * 40 + 16 * ti + 4 * fq) = pack4(y);
                    }
                }
            }
        }
        __syncthreads();
        if (wave < 4 && blk == 1) {
#pragma unroll
            for (int ti = 0; ti < 2; ++ti) {
                const bf16x8 af = *(const bf16x8*)(T22R + (16 * ti + fr) * 40 + 8 * fq);
#pragma unroll
                for (int tj = 0; tj < 2; ++tj) {
                    const bf16x8 bfr = *(const bf16x8*)(YT + (16 * tj + fr) * 40 + 8 * fq);
                    f32x4 dd = {0.f, 0.f, 0.f, 0.f}; dd = mfma16(af, bfr, dd);
#pragma unroll
                    for (int jj = 0; jj < 4; ++jj) Tbh[(32 + 16 * ti + 4 * fq + jj) * 72 + 16 * tj + fr] = f2bf(-dd[jj]);
                }
            }
        }
    }
    __syncthreads();
    {
        const int td = wave;
#pragma unroll
        for (int h = 0; h < 2; ++h) {
            const bf16_t* kb = kbgT + h * 128 * 72; const bf16_t* vb = vbT + h * 128 * 72; const bf16_t* Tb = (const bf16_t*)(Af + h * 64 * 68);
            const int unit = (b * 16 + 2 * hq + h) * 32 + c;
            const bf16x8 a0 = *(const bf16x8*)(kb + (td * 16 + fr) * 72 + fq * 8), a1 = *(const bf16x8*)(kb + (td * 16 + fr) * 72 + 32 + fq * 8);
            const bf16x8 v0 = *(const bf16x8*)(vb + (td * 16 + fr) * 72 + fq * 8), v1 = *(const bf16x8*)(vb + (td * 16 + fr) * 72 + 32 + fq * 8);
            bf16_t* W = (bf16_t*)(p.ws + OFF_GW) + (size_t)unit * 8192; bf16_t* UT = (bf16_t*)(p.ws + OFF_GUT) + (size_t)unit * 8192;
#pragma unroll
            for (int ti = 0; ti < 4; ++ti) {
                const bf16x8 t0 = *(const bf16x8*)(Tb + (ti * 16 + fr) * 72 + fq * 8), t1 = *(const bf16x8*)(Tb + (ti * 16 + fr) * 72 + 32 + fq * 8);
                f32x4 w = {0.f, 0.f, 0.f, 0.f}; w = mfma16(a0, t0, w); w = mfma16(a1, t1, w);
                *(u32x2*)(W + (ti * 16 + fr) * 128 + td * 16 + 4 * fq) = pack4(w);
                f32x4 uu = {0.f, 0.f, 0.f, 0.f}; uu = mfma16(t0, v0, uu); uu = mfma16(t1, v1, uu);
                *(u32x2*)(UT + (td * 16 + fr) * 64 + ti * 16 + 4 * fq) = pack4(uu);
            }
        }
    }
    __syncthreads();
    asm volatile("" :: "v"(pf0), "v"(pf1));
}

__device__ __forceinline__ void gdn_g2_seq(const Params& p, unsigned char* shm, int seq) {
    const int tid = otid(), lane = tid & 63, wave = tid >> 6, fr = lane & 15, fq = lane >> 4;
    const int vh = seq & 15, b = seq >> 4, hq = vh >> 1;
    bf16_t* wS = (bf16_t*)shm;
    bf16_t* qg = wS + 64 * 136;
    bf16_t* kdT = qg + 64 * 136;
    bf16_t* att = kdT + 128 * 72;
    bf16_t* vnT = att + 64 * 72;
    bf16_t* St = vnT + 128 * 72;
    float* red = (float*)(St + 128 * 136);
    const bf16_t* P = (const bf16_t*)(p.ws + OFF_PROJ);
    bf16_t* Ob = (bf16_t*)(p.ws + OFF_O);
    const float* GCUM = (const float*)(p.ws + OFF_GCUM);
    f32x4 S[8];
#pragma unroll
    for (int tk = 0; tk < 8; ++tk) { S[tk] = (f32x4){0.f, 0.f, 0.f, 0.f}; *(u32x2*)(St + (wave * 16 + fr) * 136 + tk * 16 + 4 * fq) = (u32x2){0u, 0u}; }
    const f32x4 ng = *(const f32x4*)(p.gdn_norm + wave * 16 + 4 * fq);
    u32x4 wv[2], qv[2], kv[2], av; float giv[2], glast; u32x2 utn[4], zn[4];
#define G2_LOAD(cc) do { const int unit_ = seq * 32 + (cc), uq_ = (b * 8 + hq) * 32 + (cc); \
        const bf16_t* W_ = (const bf16_t*)(p.ws + OFF_GW) + (size_t)unit_ * 8192; const bf16_t* QN_ = (const bf16_t*)(p.ws + OFF_QN) + (size_t)uq_ * 8192; const bf16_t* KN_ = (const bf16_t*)(p.ws + OFF_KN) + (size_t)uq_ * 8192; \
        const bf16_t* UT_ = (const bf16_t*)(p.ws + OFF_GUT) + (size_t)unit_ * 8192; \
        _Pragma("unroll") for (int it = 0; it < 2; ++it) { const int e = tid + 512 * it, i = e >> 4, ch = e & 15; wv[it] = *(const u32x4*)(W_ + i * 128 + ch * 8); qv[it] = *(const u32x4*)(QN_ + i * 128 + ch * 8); kv[it] = *(const u32x4*)(KN_ + i * 128 + ch * 8); giv[it] = GCUM[(size_t)unit_ * 64 + i]; } \
        { const int i = tid >> 3, ch = tid & 7; av = *(const u32x4*)((const bf16_t*)(p.ws + OFF_ATT) + (size_t)unit_ * 4096 + i * 64 + ch * 8); } \
        glast = GCUM[(size_t)unit_ * 64 + 63]; \
        _Pragma("unroll") for (int ti = 0; ti < 4; ++ti) { utn[ti] = *(const u32x2*)(UT_ + (wave * 16 + fr) * 64 + ti * 16 + 4 * fq); \
            zn[ti] = *(const u32x2*)(P + ((size_t)b * 2048 + (cc) * 64 + ti * 16 + fr) * 6400 + 4096 + vh * 128 + wave * 16 + 4 * fq); } } while (0)
    G2_LOAD(0);
#pragma unroll 1
    for (int c = 0; c < 32; ++c) {
        const int unit = seq * 32 + c, uq = (b * 8 + hq) * 32 + c;
        __syncthreads();
        const float glc = glast;
        u32x2 utr[4], zr[4];
#pragma unroll
        for (int ti = 0; ti < 4; ++ti) { utr[ti] = utn[ti]; zr[ti] = zn[ti]; }
        {
#pragma unroll
            for (int it = 0; it < 2; ++it) {
                const int e = tid + 512 * it, i = e >> 4, ch = e & 15;
                *(u32x4*)(wS + i * 136 + ch * 8) = wv[it];
                const float gi = giv[it]; const float eq = fast_exp(gi), ek = fast_exp(glc - gi);
                u32x4 qo;
#pragma unroll
                for (int q = 0; q < 4; ++q) qo[q] = cvt_pk_bf16(bflo(qv[it][q]) * eq, bfhi(qv[it][q]) * eq);
#pragma unroll
                for (int q = 0; q < 4; ++q) {
                    const int qq = (q + ch) & 3; const unsigned kw = qq == 0 ? kv[it][0] : (qq == 1 ? kv[it][1] : (qq == 2 ? kv[it][2] : kv[it][3]));
                    kdT[(ch * 8 + 2 * qq) * 72 + i] = f2bf(bflo(kw) * ek); kdT[(ch * 8 + 2 * qq + 1) * 72 + i] = f2bf(bfhi(kw) * ek);
                }
                *(u32x4*)(qg + i * 136 + ch * 8) = qo;
            }
            { const int i = tid >> 3, ch = tid & 7; *(u32x4*)(att + i * 72 + ch * 8) = av; }
        }
        if (c + 1 < 32) G2_LOAD(c + 1);
        __syncthreads();
        bf16x8 sf[4];
#pragma unroll
        for (int ks = 0; ks < 4; ++ks) sf[ks] = *(const bf16x8*)(St + (wave * 16 + fr) * 136 + ks * 32 + fq * 8);
        {
#pragma unroll
            for (int ti = 0; ti < 4; ++ti) {
                f32x4 a = {0.f, 0.f, 0.f, 0.f};
#pragma unroll
                for (int ks = 0; ks < 4; ++ks) a = mfma16(*(const bf16x8*)(wS + (ti * 16 + fr) * 136 + ks * 32 + fq * 8), sf[ks], a);
                const f32x4 uu = unpack4(utr[ti]);
                *(u32x2*)(vnT + (wave * 16 + fr) * 72 + ti * 16 + 4 * fq) = pack4(uu - a);
            }
        }
        asm volatile("s_waitcnt lgkmcnt(0)" ::: "memory");
        bf16x8 vf[2];
#pragma unroll
        for (int ks = 0; ks < 2; ++ks) vf[ks] = *(const bf16x8*)(vnT + (wave * 16 + fr) * 72 + ks * 32 + fq * 8);
        f32x4 o[4];
#pragma unroll
        for (int ti = 0; ti < 4; ++ti) {
            f32x4 a = {0.f, 0.f, 0.f, 0.f};
#pragma unroll
            for (int ks = 0; ks < 4; ++ks) a = mfma16(sf[ks], *(const bf16x8*)(qg + (ti * 16 + fr) * 136 + ks * 32 + fq * 8), a);
#pragma unroll
            for (int ks = 0; ks < 2; ++ks) a = mfma16(vf[ks], *(const bf16x8*)(att + (ti * 16 + fr) * 72 + ks * 32 + fq * 8), a);
            o[ti] = a;
            float s2 = (a[0] * a[0] + a[1] * a[1]) + (a[2] * a[2] + a[3] * a[3]);
            s2 += __shfl_xor(s2, 16); s2 += __shfl_xor(s2, 32);
            if (fq == 0) red[wave * 64 + ti * 16 + fr] = s2;
        }
        __syncthreads();
#pragma unroll
        for (int ti = 0; ti < 4; ++ti) {
            const int i = ti * 16 + fr; float tot = 0.f;
#pragma unroll
            for (int w = 0; w < 8; ++w) tot += red[w * 64 + i];
            const float rn = rsqrtf(tot * (1.0f / 128.0f) + EPS);
            const size_t row = (size_t)b * 2048 + c * 64 + i;
            const f32x4 z = unpack4(zr[ti]);
            f32x4 r;
#pragma unroll
            for (int jj = 0; jj < 4; ++jj) r[jj] = o[ti][jj] * rn * ng[jj] * siluf_(z[jj]);
            *(u32x2*)(Ob + row * 2048 + vh * 128 + wave * 16 + 4 * fq) = pack4(r);
        }
        {
            const float eg = fast_exp(glc);
#pragma unroll
            for (int tk = 0; tk < 8; ++tk) {
                f32x4 a = S[tk] * eg;
#pragma unroll
                for (int ks = 0; ks < 2; ++ks) a = mfma16(*(const bf16x8*)(kdT + (tk * 16 + fr) * 72 + ks * 32 + fq * 8), vf[ks], a);
                S[tk] = a;
                *(u32x2*)(St + (wave * 16 + fr) * 136 + tk * 16 + 4 * fq) = pack4(a);
            }
        }
    }
    float* pg = p.out + OUT_PG + (size_t)(b * 16 + vh) * 16384;
#pragma unroll
    for (int tk = 0; tk < 8; ++tk)
#pragma unroll
        for (int jj = 0; jj < 4; ++jj) pg[(tk * 16 + 4 * fq + jj) * 128 + wave * 16 + fr] = S[tk][jj];
    __syncthreads();
}

__device__ __forceinline__ void gdn_sample_item(const Params& p, unsigned char* shm, int item) {
    const int tid = otid(), lane = tid & 63, wave = tid >> 6;
    const int vh = item & 15, b = item >> 4, hq = vh >> 1;
    const bf16_t* P = (const bf16_t*)(p.ws + OFF_PROJ);
    const float* BA = (const float*)(p.ws + OFF_BA);
    bf16_t* Ob = (bf16_t*)(p.ws + OFF_O);
    float* qs = (float*)shm; float* ks = qs + 512; float* vs = ks + 512; float* red = vs + 512; float* sc = red + 4096; float* part = sc + 16;
    const int t = tid >> 7, col = tid & 127;
    const int dv = tid & 127, grp = tid >> 7;
    float s[32];
    {
        const float* sp = p.state_gdn + (size_t)(b * 16 + vh) * 16384;
#pragma unroll
        for (int e = 0; e < 32; ++e) s[e] = sp[(grp * 32 + e) * 128 + dv];
    }
    bf16_t zg[4];
#pragma unroll
    for (int tt = 0; tt < 4; ++tt) zg[tt] = P[(size_t)(MP + b * 4 + tt) * 6400 + 4096 + vh * 128 + dv];
    const float ngd = p.gdn_norm[dv];
    __syncthreads();
#pragma unroll
    for (int op = 0; op < 3; ++op) {
        const int cc = op == 0 ? hq * 128 + col : (op == 1 ? 1024 + hq * 128 + col : 2048 + vh * 128 + col);
        float acc = 0.f, xlast = 0.f;
#pragma unroll
        for (int jj = 0; jj < 4; ++jj) {
            const int xi = t + jj;
            const float x = xi < 3 ? p.state_conv[(size_t)(b * 3 + xi) * 4096 + cc] : bf2f(P[(size_t)(MP + b * 4 + xi - 3) * 6400 + cc]);
            acc += x * p.gdn_conv_w[jj * 4096 + cc]; xlast = x;
        }
        if (t >= 1 && (op == 2 || (vh & 1) == 0)) p.out[OUT_SC + (size_t)(b * 3 + t - 1) * 4096 + cc] = xlast;
        acc = siluf_(acc);
        (op == 0 ? qs : (op == 1 ? ks : vs))[tid] = acc;
    }
    if (tid < 4) {
        const size_t r = MP + b * 4 + tid;
        const float a = BA[r * 32 + 16 + vh] + p.gdn_dt_bias[vh];
        const float sp = a > 20.f ? a : log1pf(expf(a));
        sc[tid] = -expf(p.gdn_a_log[vh]) * sp; sc[4 + tid] = 1.0f / (1.0f + expf(-BA[r * 32 + vh]));
    }
    __syncthreads();
    {
        const float q = qs[tid], k = ks[tid];
        const float sq = wave_sum(q * q), sk = wave_sum(k * k);
        if (lane == 0) { part[wave] = sq; part[8 + wave] = sk; }
        __syncthreads();
        const float tq = part[2 * t] + part[2 * t + 1], tk = part[8 + 2 * t] + part[8 + 2 * t + 1];
        qs[tid] = q * rsqrtf(tq + 1e-6f) * 0.08838834764831845f; ks[tid] = k * rsqrtf(tk + 1e-6f);
    }
    __syncthreads();
#pragma unroll
    for (int tt = 0; tt < 4; ++tt) {
        const float eg = fast_exp(sc[tt]), be = sc[4 + tt];
        float r = 0.f;
#pragma unroll
        for (int e = 0; e < 32; ++e) { s[e] *= eg; r += s[e] * ks[tt * 128 + grp * 32 + e]; }
        float* rr_ = red + tt * 1024; float* ro_ = rr_ + 512; float* pt_ = part + 16 + tt * 8;
        rr_[grp * 128 + dv] = r;
        __syncthreads();
        const float rt = (rr_[dv] + rr_[128 + dv]) + (rr_[256 + dv] + rr_[384 + dv]);
        const float delta = be * (vs[tt * 128 + dv] - rt);
        float o = 0.f;
#pragma unroll
        for (int e = 0; e < 32; ++e) { s[e] += ks[tt * 128 + grp * 32 + e] * delta; o += s[e] * qs[tt * 128 + grp * 32 + e]; }
        ro_[grp * 128 + dv] = o;
        __syncthreads();
        const float ot = (ro_[dv] + ro_[128 + dv]) + (ro_[256 + dv] + ro_[384 + dv]);
        const float so = wave_sum(ot * ot);
        if (lane == 0) pt_[wave] = so;
        __syncthreads();
        const float rn = rsqrtf((pt_[2 * grp] + pt_[2 * grp + 1]) * (1.0f / 128.0f) + EPS);
        if (grp == 0) {
            const size_t row = MP + b * 4 + tt;
            const float z = bf2f(zg[tt]);
            Ob[row * 2048 + vh * 128 + dv] = f2bf(ot * rn * ngd * siluf_(z));
        }
    }
    float* sg = p.out + OUT_SG + (size_t)(b * 16 + vh) * 16384;
#pragma unroll
    for (int e = 0; e < 32; ++e) sg[(grp * 32 + e) * 128 + dv] = s[e];
}

__device__ __forceinline__ void hgrn_seq(const Params& p, unsigned char* shm, int seq) {
    const int tid = otid(), lane = tid & 63, wave = tid >> 6, fr = lane & 15, fq = lane >> 4;
    const int h = seq & 7, b = seq >> 3;
    bf16_t* qS = (bf16_t*)shm;
    bf16_t* qe = qS + 32 * 136;
    bf16_t* ke = qe + 32 * 136;
    bf16_t* kST = ke + 32 * 136;
    bf16_t* vT = kST + 128 * 40;
    bf16_t* att = vT + 128 * 40;
    bf16_t* St = att + 32 * 40;
    float* offs = (float*)(St + 128 * 136);
    float* elast = offs + 1024;
    float* red = elast + 128;
    const bf16_t* P = (const bf16_t*)(p.ws + OFF_PROJ);
    const float* FZ = (const float*)(p.ws + OFF_FZ);
    bf16_t* Ob = (bf16_t*)(p.ws + OFF_O);
    const int d = tid & 127, rg = tid >> 7;
    const float lb = ((const float*)(p.ws + OFF_LB))[h * 128 + d];
    f32x4 S[8];
#pragma unroll
    for (int tk = 0; tk < 8; ++tk) { S[tk] = (f32x4){0.f, 0.f, 0.f, 0.f}; *(u32x2*)(St + (wave * 16 + fr) * 136 + tk * 16 + 4 * fq) = (u32x2){0u, 0u}; }
    const f32x4 ng = *(const f32x4*)(p.hgrn_norm + wave * 16 + 4 * fq);
    float fzn[8]; bf16_t qn_[8], vn_[8]; u32x2 zn_[2];
    {
        const size_t r00 = (size_t)b * 2048;
#pragma unroll
        for (int e = 0; e < 8; ++e) { const size_t r = r00 + rg * 8 + e; fzn[e] = FZ[r * 1024 + h * 128 + d]; qn_[e] = P[r * 4096 + h * 128 + d]; vn_[e] = P[r * 4096 + 2048 + h * 128 + d]; }
#pragma unroll
        for (int ti = 0; ti < 2; ++ti) zn_[ti] = *(const u32x2*)(P + (r00 + ti * 16 + fr) * 4096 + 3072 + h * 128 + wave * 16 + 4 * fq);
    }
#pragma unroll 1
    for (int c = 0; c < 64; ++c) {
        const size_t r0 = (size_t)b * 2048 + c * 32;
        float lf[8], kk[8], qq[8], vv[8];
#pragma unroll
        for (int e = 0; e < 8; ++e) {
            const float fz = fminf(fmaxf(fzn[e], -60.f), 60.f);
            const float e1 = fast_exp(-fz), sg = __builtin_amdgcn_rcpf(1.0f + e1), sn = e1 * sg;
            lf[e] = fast_log(lb + (1.0f - lb) * sg); kk[e] = (1.0f - lb) * sn;
            qq[e] = siluf_(bf2f(qn_[e])); vv[e] = bf2f(vn_[e]);
        }
        u32x2 zcur[2] = {zn_[0], zn_[1]};
        if (c + 1 < 64) {
#pragma unroll
            for (int e = 0; e < 8; ++e) { const size_t r = r0 + 32 + rg * 8 + e; fzn[e] = FZ[r * 1024 + h * 128 + d]; qn_[e] = P[r * 4096 + h * 128 + d]; vn_[e] = P[r * 4096 + 2048 + h * 128 + d]; }
#pragma unroll
            for (int ti = 0; ti < 2; ++ti) zn_[ti] = *(const u32x2*)(P + (r0 + 32 + ti * 16 + fr) * 4096 + 3072 + h * 128 + wave * 16 + 4 * fq);
        }
        float cs[8]; float run = 0.f;
#pragma unroll
        for (int e = 0; e < 8; ++e) { run += lf[e]; cs[e] = run; }
        float* ofs = offs + (c & 1) * 512;
        ofs[rg * 128 + d] = run;
        __syncthreads();
        const float o0 = ofs[d], o1 = ofs[128 + d], o2 = ofs[256 + d], o3 = ofs[384 + d];
        const float base = rg == 0 ? 0.f : (rg == 1 ? o0 : (rg == 2 ? o0 + o1 : o0 + o1 + o2));
        const float tot = (o0 + o1) + (o2 + o3), bref = o0 + o1;
        const float Etot = fast_exp(tot), Eref = fast_exp(bref), Erefi = fast_exp(fminf(-bref, 85.f));
        float Ebc[8], Einv[8];
#pragma unroll
        for (int e = 0; e < 8; ++e) { const float bc = base + cs[e]; Ebc[e] = fast_exp(bc); Einv[e] = fast_exp(fminf(-bc, 85.f)); }
        u32x4 kw, vw;
#pragma unroll
        for (int e = 0; e < 8; e += 2) {
            kw[e >> 1] = cvt_pk_bf16(kk[e] * Einv[e] * Etot, kk[e + 1] * Einv[e + 1] * Etot);
            vw[e >> 1] = cvt_pk_bf16(vv[e], vv[e + 1]);
        }
        *(u32x4*)(kST + d * 40 + rg * 8) = kw; *(u32x4*)(vT + d * 40 + rg * 8) = vw;
#pragma unroll
        for (int e = 0; e < 8; ++e) {
            const float bc = base + cs[e]; const int i = rg * 8 + e;
            const float qE = qq[e] * Ebc[e];
            qS[i * 136 + d] = f2bf(qE); qe[i * 136 + d] = f2bf(qE * Erefi); ke[i * 136 + d] = f2bf(kk[e] * Einv[e] * Eref);
        }
        if (rg == 0) elast[d] = Etot;
        __syncthreads();
        bf16x8 sf[4];
#pragma unroll
        for (int ks = 0; ks < 4; ++ks) sf[ks] = *(const bf16x8*)(St + (wave * 16 + fr) * 136 + ks * 32 + fq * 8);
        const bf16x8 vf = *(const bf16x8*)(vT + (wave * 16 + fr) * 40 + fq * 8);
        const bf16x8 vperm = cat8(*(const u32x2*)(vT + (wave * 16 + fr) * 40 + 4 * fq), *(const u32x2*)(vT + (wave * 16 + fr) * 40 + 16 + 4 * fq));
        f32x4 o[2];
#pragma unroll
        for (int ti = 0; ti < 2; ++ti) {
            f32x4 a = {0.f, 0.f, 0.f, 0.f};
#pragma unroll
            for (int ks = 0; ks < 4; ++ks) a = mfma16(sf[ks], *(const bf16x8*)(qS + (ti * 16 + fr) * 136 + ks * 32 + fq * 8), a);
            {
                f32x4 at0 = {0.f, 0.f, 0.f, 0.f}, at1 = {0.f, 0.f, 0.f, 0.f};
#pragma unroll
                for (int ks = 0; ks < 4; ++ks) {
                    const bf16x8 qf = *(const bf16x8*)(qe + (ti * 16 + fr) * 136 + ks * 32 + fq * 8);
                    at0 = mfma16(*(const bf16x8*)(ke + fr * 136 + ks * 32 + fq * 8), qf, at0);
                    at1 = mfma16(*(const bf16x8*)(ke + (16 + fr) * 136 + ks * 32 + fq * 8), qf, at1);
                }
                const int irow = ti * 16 + fr;
#pragma unroll
                for (int jj = 0; jj < 4; ++jj) { if (4 * fq + jj > irow) at0[jj] = 0.f; if (16 + 4 * fq + jj > irow) at1[jj] = 0.f; }
                a = mfma16(vperm, cat8(pack4(at0), pack4(at1)), a);
            }
            o[ti] = a;
            float s2 = (a[0] * a[0] + a[1] * a[1]) + (a[2] * a[2] + a[3] * a[3]);
            s2 += __shfl_xor(s2, 16); s2 += __shfl_xor(s2, 32);
            if (fq == 0) red[wave * 32 + ti * 16 + fr] = s2;
        }
        __syncthreads();
#pragma unroll
        for (int ti = 0; ti < 2; ++ti) {
            const int i = ti * 16 + fr; float tt = 0.f;
#pragma unroll
            for (int w = 0; w < 8; ++w) tt += red[w * 32 + i];
            const float rn = rsqrtf(tt * (1.0f / 128.0f) + EPS);
            const size_t row = r0 + i;
            const f32x4 z = unpack4(zcur[ti]);
            f32x4 r;
#pragma unroll
            for (int jj = 0; jj < 4; ++jj) r[jj] = o[ti][jj] * rn * ng[jj] * siluf_(z[jj]);
            *(u32x2*)(Ob + row * 1024 + h * 128 + wave * 16 + 4 * fq) = pack4(r);
        }
#pragma unroll
        for (int tk = 0; tk < 8; ++tk) {
            const f32x4 el = *(const f32x4*)(elast + tk * 16 + 4 * fq);
            f32x4 a = S[tk] * el;
            a = mfma16(*(const bf16x8*)(kST + (tk * 16 + fr) * 40 + fq * 8), vf, a);
            S[tk] = a;
            *(u32x2*)(St + (wave * 16 + fr) * 136 + tk * 16 + 4 * fq) = pack4(a);
        }
    }
    float* ph = p.out + OUT_PH + (size_t)(b * 8 + h) * 16384;
#pragma unroll
    for (int tk = 0; tk < 8; ++tk)
#pragma unroll
        for (int jj = 0; jj < 4; ++jj) ph[(tk * 16 + 4 * fq + jj) * 128 + wave * 16 + fr] = S[tk][jj];
    __syncthreads();
}

__device__ __forceinline__ void hgrn_sample_item(const Params& p, unsigned char* shm, int item) {
    const int tid = otid(), lane = tid & 63, wave = tid >> 6;
    const int h = item & 7, b = item >> 3;
    const bf16_t* P = (const bf16_t*)(p.ws + OFF_PROJ);
    const float* FZ = (const float*)(p.ws + OFF_FZ);
    bf16_t* Ob = (bf16_t*)(p.ws + OFF_O);
    float* fs = (float*)shm; float* ks = fs + 512; float* qs = ks + 512; float* vs = qs + 512; float* red = vs + 512; float* part = red + 512;
    const int t = tid >> 7, d = tid & 127;
    __syncthreads();
    {
        const size_t r = MP + b * 4 + t;
        const float lb = ((const float*)(p.ws + OFF_LB))[h * 128 + d];
        const float fz = FZ[r * 1024 + h * 128 + d];
        const float sg = __builtin_amdgcn_rcpf(1.0f + fast_exp(-fz)), sn = __builtin_amdgcn_rcpf(1.0f + fast_exp(fz));
        fs[tid] = lb + (1.0f - lb) * sg; ks[tid] = (1.0f - lb) * sn;
        qs[tid] = siluf_(bf2f(P[r * 4096 + h * 128 + d])); vs[tid] = bf2f(P[r * 4096 + 2048 + h * 128 + d]);
    }
    __syncthreads();
    const int dv = tid & 127, grp = tid >> 7;
    float s[32];
    const float* sp = p.state_hgrn + (size_t)(b * 8 + h) * 16384;
#pragma unroll
    for (int e = 0; e < 32; ++e) s[e] = sp[(grp * 32 + e) * 128 + dv];
#pragma unroll 1
    for (int tt = 0; tt < 4; ++tt) {
        const float v = vs[tt * 128 + dv]; float o = 0.f;
#pragma unroll
        for (int e = 0; e < 32; ++e) { const int dk = tt * 128 + grp * 32 + e; s[e] = fs[dk] * s[e] + ks[dk] * v; o += s[e] * qs[dk]; }
        red[grp * 128 + dv] = o;
        __syncthreads();
        const float ot = (red[dv] + red[128 + dv]) + (red[256 + dv] + red[384 + dv]);
        const float so = wave_sum(ot * ot);
        if (lane == 0) part[wave] = so;
        __syncthreads();
        const float rn = rsqrtf((part[2 * grp] + part[2 * grp + 1]) * (1.0f / 128.0f) + EPS);
        if (grp == 0) {
            const size_t row = MP + b * 4 + tt;
            const float z = bf2f(P[row * 4096 + 3072 + h * 128 + dv]);
            Ob[row * 1024 + h * 128 + dv] = f2bf(ot * rn * p.hgrn_norm[dv] * siluf_(z));
        }
        __syncthreads();
    }
    float* sh = p.out + OUT_SH + (size_t)(b * 8 + h) * 16384;
#pragma unroll
    for (int e = 0; e < 32; ++e) sh[(grp * 32 + e) * 128 + dv] = s[e];
}

__device__ __forceinline__ void touch_resid_tile(const Params& p) {
    pg8::StaticOrder so; so.init(M_TOK, 1024, gridDim.x, obid());
    Unit u;
    if (!so.next(0, u)) return;
    const int tid = otid();
    const float* base = p.out + (size_t)u.pm * 256 * 1024 + u.pn * 256;
#pragma unroll
    for (int k = 0; k < 4; ++k) { const int line = tid + 512 * k; (void)*(const volatile float*)(base + (size_t)(line >> 3) * 1024 + (line & 7) * 32); }
}
__device__ __forceinline__ void fill_rs_table(const pg8::StaticOrder& so, const float* ss, PG8_LAS float* rsb) {
    const int t = otid();
    f32x4 pa[7][4]; int rowi[7];
#pragma unroll
    for (int i = 0; i < 7; ++i) {
        Unit uu; rowi[i] = so.next(i, uu) ? uu.pm * 256 + t : -1;
        if (rowi[i] >= 0 && t < 256) { const f32x4* sp = (const f32x4*)(ss + (size_t)rowi[i] * 16); pa[i][0] = sp[0]; pa[i][1] = sp[1]; pa[i][2] = sp[2]; pa[i][3] = sp[3]; }
    }
#pragma unroll
    for (int i = 0; i < 7; ++i)
        if (rowi[i] >= 0 && t < 256) { const f32x4 q = (pa[i][0] + pa[i][1]) + (pa[i][2] + pa[i][3]); rsb[i * 256 + t] = rsqrtf(((q[0] + q[1]) + (q[2] + q[3])) * (1.0f / 1024.0f) + EPS); }
    __syncthreads();
}
__device__ __forceinline__ void run_phase(const Params& p, unsigned char* shm, int code) {

#ifndef NO_PRO
    if (code == 0xF0) { ph_prologue(p, shm); return; }
#endif

    if (code == 0xF1) { ph_final(p); return; }
    const bool dry = (code & 0x40) != 0; code &= 0x3f;
    const int layer = code >> 4, sub = code & 15, kind = layer % 3, jm = layer / 3;
    float* SS = (float*)(p.ws + OFF_SS);
    bf16_t* XG = (bf16_t*)(p.ws + OFF_XG); bf16_t* HID = (bf16_t*)(p.ws + OFF_HID); bf16_t* PROJ = (bf16_t*)(p.ws + OFF_PROJ); bf16_t* Ob = (bf16_t*)(p.ws + OFF_O);
    PG8_LAS unsigned char* lds = (PG8_LAS unsigned char*)shm;
    pg8::StaticOrder so;
    if (sub == 0 || sub == 6) {
        const int s = sub == 0 ? 0 : 1;
        pg8::Gemm g; g.A = XG; g.Bt = (const bf16_t*)(p.ws + WT_FFN_IN) + (size_t)(layer * 2 + s) * 5632 * 1024; g.M = M_TOK; g.N = 5632; g.K = 1024; g.ld = 1024;
        EpiSwiglu e; e.rsb = (PG8_LAS float*)(lds + RS_LDS_OFF); e.H = HID; e.ss = SS + (size_t)((3 * layer + (s ? 2 : 0)) & 1) * M_TOK * 16;
        so.init(g.M, g.N, gridDim.x, obid());
        fill_rs_table(so, e.ss, e.rsb);
#ifndef NO_GE1
 pg8::gemm_phase<EpiSwiglu, pg8::StaticOrder, false>(lds, g, so, e, nullptr);
#endif

    } else if (sub == 1 || sub == 5 || sub == 7) {
        pg8::Gemm g; EpiResid e; e.X = p.out; e.XG = XG; g.M = M_TOK; g.N = 1024;
        if (sub == 1) { g.A = HID; g.K = DFF; g.Bt = (const bf16_t*)(p.ws + WT_FFN_OUT) + (size_t)(layer * 2) * 1024 * DFF; e.scale = 0.5f; e.iscale = 2.0f; e.g = p.norm_mix + layer * 1024; e.ssn = SS + (size_t)((3 * layer + 1) & 1) * M_TOK * 16; }
        else if (sub == 7) { g.A = HID; g.K = DFF; g.Bt = (const bf16_t*)(p.ws + WT_FFN_OUT) + (size_t)(layer * 2 + 1) * 1024 * DFF; e.scale = 0.5f; e.iscale = 2.0f; e.g = layer < 3 ? p.norm_ffn + (size_t)((layer + 1) * 2) * 1024 : p.final_norm; e.ssn = SS + (size_t)((3 * layer + 3) & 1) * M_TOK * 16; }
        else { g.A = Ob; e.scale = 1.0f; e.iscale = 1.0f; e.g = p.norm_ffn + (size_t)(layer * 2 + 1) * 1024; e.ssn = SS + (size_t)((3 * layer + 2) & 1) * M_TOK * 16;
            if (kind == 0) { g.K = 1024; g.Bt = (const bf16_t*)(p.ws + WT_SWA_OUT) + (size_t)jm * 1024 * 1024; }
            else if (kind == 1) { g.K = 2048; g.Bt = (const bf16_t*)(p.ws + WT_GDN_OUT); }
            else { g.K = 1024; g.Bt = (const bf16_t*)(p.ws + WT_HG_OUT); } }
        e.pm0 = 0; g.ld = g.K; g.M = USE_SPLIT ? MP : M_TOK;
        so.init(g.M, g.N, gridDim.x, obid());
#ifndef NO_GE2
        {
            const int bid = obid(), KT = g.K >> 6, q = KT >> 2, sp = bid >> 3, u8 = bid & 7;
            const int big = (q & 1) ? q + 1 : q, small = (q & 1) ? q - 1 : q;
            const int k0 = (sp < 2 ? sp * big : 2 * big + (sp - 2) * small) * 64, len = (sp < 2 ? big : small) * 64;
            pg8::Gemm g2 = g; g2.A = g.A + k0; g2.Bt = g.Bt + k0; g2.K = len; g2.M = M_TOK;
            OneUnit ou; ou.have = bid < 32; ou.pm = 64 + (u8 >> 2); ou.pn = u8 & 3;
            EpiSplit es; es.R = e; es.part = (float*)(p.ws + OFF_PART); es.cnt = (unsigned*)(p.ws + OFF_CNT) + (layer * 3 + (sub == 1 ? 0 : (sub == 5 ? 1 : 2))) * 8; es.unit8 = u8; es.split = sp; es.ns = 4;
#if USE_SPLIT
            pg8::gemm_phase<EpiSplit, OneUnit, false>(lds, g2, ou, es, nullptr);
#endif
        }
        pg8::gemm_phase<EpiResid, pg8::StaticOrder, false>(lds, g, so, e, nullptr);
        if (obid() >= 8) convert_weights(p, shm, 1 + layer * 3 + (sub == 1 ? 0 : (sub == 5 ? 1 : 2)), obid() - 8, gridDim.x - 8);
#endif

    } else if (sub == 2) {
        pg8::Gemm g; g.A = XG; g.M = M_TOK; g.K = 1024; g.ld = 1024; EpiProj e; e.rsb = (PG8_LAS float*)(lds + RS_LDS_OFF); e.P = PROJ; e.ss = SS + (size_t)((3 * layer + 1) & 1) * M_TOK * 16; e.mode = kind; e.rope = (const float*)(p.ws + OFF_ROPE);
        if (kind == 0) { g.N = 1536; g.Bt = (const bf16_t*)(p.ws + WT_SWA_IN) + (size_t)jm * 1536 * 1024; e.side = nullptr; }
        else if (kind == 1) { g.N = 6400; g.Bt = (const bf16_t*)(p.ws + WT_GDN_IN); e.side = (float*)(p.ws + OFF_BA); }
        else { g.N = 4096; g.Bt = (const bf16_t*)(p.ws + WT_HG_IN); e.side = (float*)(p.ws + OFF_FZ); }
        e.ld = g.N;
        so.init(g.M, g.N, gridDim.x, obid());
        fill_rs_table(so, e.ss, e.rsb);
#ifndef NO_GE3
 pg8::gemm_phase<EpiProj, pg8::StaticOrder, false>(lds, g, so, e, nullptr);
#endif

    } else if (sub == 3) {
        if (kind == 0) {
            for (int it = obid(); it < 1024; it += gridDim.x) {
#ifndef NO_SWAP
 if (it < 512) swa_prompt_item(p, shm, jm, it);
#endif
#ifndef NO_SWAS
 if (it >= 512) swa_sample_item(p, shm, jm, it - 512);
#endif
 }
            } else if (kind == 1) {

#ifndef NO_G1
#if G1_PAIR
 for (int u = obid(); u < 2048; u += gridDim.x) gdn_g1_pair(p, shm, u);
#if GS_EARLY
 for (int it = obid(); it < GS_EARLY; it += gridDim.x) gdn_sample_item(p, shm, it);
#endif
#else
 for (int u = obid(); u < 4096; u += gridDim.x) gdn_g1_unit(p, shm, u);
#endif
#endif

        } else {

#ifndef NO_HG
 if (obid() < 64) hgrn_seq(p, shm, obid());
#endif


#ifndef NO_HGS
 if (obid() >= 64) for (int it = obid() - 64; it < 1024; it += gridDim.x - 64) hgrn_sample_item(p, shm, it);
#endif

        }
    } else if (sub == 4) {

#ifndef NO_G2
 if (obid() < 128) gdn_g2_seq(p, shm, obid());
#endif


#ifndef NO_GS
 if (obid() >= 128) for (int it = GS_EARLY + obid() - 128; it < 2048; it += gridDim.x - 128) gdn_sample_item(p, shm, it);
#endif

    }
}

__global__ __launch_bounds__(512, 2) void mega(Params p, int ph_lo, int ph_hi) {
    extern __shared__ __attribute__((aligned(16))) unsigned char shm[];
    cg::grid_group grid = cg::this_grid();
    volatile LAS unsigned* st = (volatile LAS unsigned*)(shm + LDS_PHASE);
    if (threadIdx.x < 4) st[threadIdx.x] = 0u;
    __syncthreads();
    XcdBarrier xb = xcd_barrier_post((unsigned*)(p.ws + OFF_BAR), st);
    for (int ph = ph_lo; ph < ph_hi; ++ph) {
        run_phase(p, shm, p.prog[ph]);
        if (ph + 1 < ph_hi) { if (p.nprog < 0) grid.sync(); else xcd_barrier(xb);
#if REP_SYNC
            xcd_barrier(xb); xcd_barrier(xb);
#endif
        }
    }
}

extern "C" void kernel_launch(void* const* d_in, const int* in_sizes, int n_in, void* d_out, int out_size, void* d_ws, size_t ws_size, hipStream_t stream) {
    static int grid_blocks = 0;
    if (grid_blocks == 0) {
        if (n_in != 25 || (size_t)out_size != OUT_END || ws_size < WS_END) { fprintf(stderr, "kernel_launch: unexpected shapes n_in %d out %d ws %zu (need %zu)\n", n_in, out_size, ws_size, (size_t)WS_END); grid_blocks = -1; return; }
        int dev = 0, cus = 0, per_cu = 0;
        hipGetDevice(&dev); hipDeviceGetAttribute(&cus, hipDeviceAttributeMultiprocessorCount, dev);
        if (hipFuncSetAttribute((const void*)mega, hipFuncAttributeMaxDynamicSharedMemorySize, LDS_BYTES) != hipSuccess) { fprintf(stderr, "kernel_launch: hipFuncSetAttribute failed\n"); grid_blocks = -1; return; }
        if (hipOccupancyMaxActiveBlocksPerMultiprocessor(&per_cu, (const void*)mega, 512, LDS_BYTES) != hipSuccess || per_cu < 1) { fprintf(stderr, "kernel_launch: occupancy query gave %d\n", per_cu); per_cu = 1; }
        (void)hipGetLastError();
        grid_blocks = cus * 1;
    }
    if (grid_blocks < 0) return;
    Params p{};
    const float** f = (const float**)&p.x_prompt;
    for (int i = 0; i < 25; ++i) f[i] = (const float*)d_in[i];
    p.out = (float*)d_out; p.ws = (unsigned char*)d_ws;
    for (int i = 0; i < 8; ++i) p.inv_freq[i] = (float)pow(500000.0, -(double)i / 8.0);
    {
        int n = 0, t0 = 0; unsigned char* ws = (unsigned char*)d_ws;
        auto add = [&](const float* src, size_t dst_off, int K, int N, int Nrows, int mode) { WD& w = p.wd[n++]; w.src = src; w.dst = (bf16_t*)(ws + dst_off); w.K = K; w.N = N; w.Nrows = Nrows; w.mode = mode; w.tile0 = t0; w.pad = 0; t0 += (K / 128) * (Nrows / 64); };
        auto fin = [&](int i) { add(p.ffn_w_in + (size_t)i * 1024 * 5632, WT_FFN_IN + (size_t)i * 5632 * 1024 * 2, 1024, 5632, 5632, 1); };
        auto fout = [&](int i) { add(p.ffn_w_out + (size_t)i * DFF * 1024, WT_FFN_OUT + (size_t)i * 1024 * DFF * 2, DFF, 1024, 1024, 0); };
        auto swa = [&](int i) { add(p.swa_w_in + (size_t)i * 1024 * 1536, WT_SWA_IN + (size_t)i * 1536 * 1024 * 2, 1024, 1536, 1536, 0);
                                add(p.swa_w_out + (size_t)i * 1024 * 1024, WT_SWA_OUT + (size_t)i * 1024 * 1024 * 2, 1024, 1024, 1024, 0); };
        int gi = 0;
        auto grp = [&]() { p.wg_desc[gi] = n; p.wg_tile[gi] = t0; ++gi; };
        grp(); fin(0); fout(0);
        grp(); swa(0); fin(1);
        grp(); fout(1); fin(2);
        grp(); fout(2); add(p.gdn_w_in, WT_GDN_IN, 1024, 6176, 6400, 0);
        grp(); add(p.gdn_w_out, WT_GDN_OUT, 2048, 1024, 1024, 0); fin(3);
        grp(); fout(3); fin(4);
        grp(); fout(4); add(p.hgrn_w_in, WT_HG_IN, 1024, 4096, 4096, 0); add(p.hgrn_w_out, WT_HG_OUT, 1024, 1024, 1024, 0);
        grp(); fin(5);
        grp(); fout(5); fin(6);
        grp(); fout(6); swa(1);
        grp(); fin(7);
        grp(); fout(7);
        grp();
        grp();
        p.wd_total = t0;
    }
    {
        int n = 0; p.prog[n++] = 0xF0; if (REP_PRO) p.prog[n++] = 0xF0;
        for (int l = 0; l < NLAYERS; ++l) for (int s = 0; s < 8; ++s) {
            if (s == 4 && (l % 3) != 1) continue;
            const bool is_resid = (s == 1 || s == 5 || s == 7), is_core = (s == 3 || s == 4);
            if (REP_GEMM && !is_core && ((REP_GEMM >> (is_resid ? 1 : (s == 2 ? 2 : 0))) & 1)) p.prog[n++] = (unsigned char)(l * 16 + s + (is_resid ? 0x40 : 0));
            if (is_core && ((REP_CORE >> ((l % 3) == 0 ? 0 : ((l % 3) == 2 ? 3 : (s == 3 ? 1 : 2)))) & 1)) p.prog[n++] = (unsigned char)(l * 16 + s);
            p.prog[n++] = (unsigned char)(l * 16 + s);
        }
        p.prog[n++] = 0xF1; p.nprog = n;
    }
#if MULTI_LAUNCH
    for (int ph = 0; ph < p.nprog; ++ph) hipLaunchKernelGGL(mega, dim3(grid_blocks), dim3(512), LDS_BYTES, stream, p, ph, ph + 1);
#else
    (void)hipMemsetAsync((unsigned char*)d_ws + OFF_BAR, 0, XCD_BAR_WORDS * 4, stream);
    int lo = 0, hi = p.nprog;
    void* args[] = {&p, &lo, &hi};
    hipError_t e = hipLaunchCooperativeKernel((const void*)mega, dim3(grid_blocks), dim3(512), args, LDS_BYTES, stream);
    if (e != hipSuccess) fprintf(stderr, "kernel_launch: cooperative launch failed: %s\n", hipGetErrorString(e));
#endif
}
```

```cpp
#include <hip/hip_runtime.h>
#include <hip/hip_cooperative_groups.h>
#include <cstdio>
#include <cmath>
namespace cg = cooperative_groups;
namespace pg8 {
#define PG8_LAS __attribute__((address_space(3)))
typedef unsigned short bf16_t;
typedef short bf16x8 __attribute__((ext_vector_type(8)));
typedef float f32x4 __attribute__((ext_vector_type(4)));
typedef unsigned u32x4 __attribute__((ext_vector_type(4)));
constexpr int BM = 256, BK = 64, HALF = 128, HTB = HALF * BK * 2  , STAGE_BYTES = 8 * HTB, NXCD = 8, WGM = 8;

__host__ __device__ __forceinline__ int lds_byte(int r, int c) { const int st = (r >> 4) * 2 + (c >> 5), rr = r & 15, cc = c & 31, ob = rr * 64 + cc * 2; return st * 1024 + (ob ^ (((ob >> 9) & 1) << 5)); }
__host__ __device__ __forceinline__ void stage_rc(int b, int& R, int& C) { const int st = b / 1024, sb = b % 1024, swz = sb ^ (((sb >> 9) & 1) << 5); R = (st >> 1) * 16 + swz / 64; C = (st & 1) * 32 + (swz % 64) / 2; }
__host__ __device__ __forceinline__ int perm32(int rho) { const int n = rho >> 4, i = rho & 15; return 8 * (i >> 2) + 4 * n + (i & 3); }

struct Unit { int pm, pn, idx; };
struct Gemm { const bf16_t* A; const bf16_t* Bt; int M, N, K, ld; };

struct StaticOrder {
    int nM, nN, nwg, G, c;
    __host__ __device__ void init(int M, int N, int G_, int c_) { nM = M / BM; nN = N / BM; nwg = nM * nN; G = G_; c = c_; }
    __host__ __device__ bool next(int i, Unit& u) const {
        const long L = (long)i * G + c; if (L >= nwg) return false;
        int wgid = (int)L; { const int q = nwg / NXCD, r = nwg % NXCD, xcd = wgid % NXCD, off = wgid / NXCD; wgid = (xcd < r ? xcd * (q + 1) : r * (q + 1) + (xcd - r) * q) + off; }
        const int nig = WGM * nN, gid = wgid / nig, fm = gid * WGM, gsz = (nM - fm) < WGM ? (nM - fm) : WGM;
        u.pm = fm + ((wgid % nig) % gsz); u.pn = (wgid % nig) / gsz; u.idx = i; return true;
    }
    __device__ __forceinline__ void a_ready(const Unit&) const {}
    __device__ __forceinline__ void done(const Unit&) const {}
};
typedef __bf16 bf16v2_t __attribute__((ext_vector_type(2)));
__device__ __forceinline__ unsigned cvt_pk_bf16(float lo, float hi) { float __attribute__((ext_vector_type(2))) v = {lo, hi}; return __builtin_bit_cast(unsigned, __builtin_convertvector(v, bf16v2_t)); }
typedef float f32x2 __attribute__((ext_vector_type(2)));
template <class Epi, class Sched, bool STAMP = false>
__device__ __forceinline__ void gemm_phase(PG8_LAS unsigned char* lds, const Gemm g, const Sched& S, const Epi& E, unsigned long long* stamps) {
    int tid_ = threadIdx.x; asm volatile("" : "+v"(tid_)); const int tid = tid_, wid = __builtin_amdgcn_readfirstlane(tid >> 6), lane = tid & 63, wr = wid >> 2, wc = wid & 3, fr = lane & 15, fq = lane >> 4;
    const int K = g.K, nt = K / BK, LD = g.ld;
    int ts_lo = 0, ts_hi = 0, nts = 0; const unsigned long long rt_entry = STAMP ? (unsigned long long)wall_clock64() : 0ull;
#define PG8_STAMP() do { if (STAMP && wid == 0 && nts < 64) { const unsigned long long _c = (unsigned long long)clock64(); \
        ts_lo = (lane == nts) ? (int)(unsigned)_c : ts_lo; ts_hi = (lane == nts) ? (int)(unsigned)(_c >> 32) : ts_hi; ++nts; } } while (0)
    PG8_STAMP();
    unsigned voffA[2], voffB[2];
#pragma unroll
    for (int i = 0; i < 2; ++i) { int R, C; stage_rc(tid * 16 + i * 8192, R, C); const int Rb = Epi::PERM ? ((R & ~31) + perm32(R & 31)) : R;
        voffA[i] = (unsigned)(R * LD + C) * 2u; voffB[i] = (unsigned)(Rb * LD + C) * 2u; }
    const size_t kstep = (size_t)(BK * 2);
    const size_t hstep = (size_t)HALF * LD * 2;
    const size_t tstep = 2 * hstep;
    const unsigned ldsw = (unsigned)wid * 1024u;
    const int aoff = lds_byte(wr * 64 + fr, fq * 8), boff = lds_byte(wc * 32 + fr, fq * 8);
#define PG8_SA(b, h) (((b) * 2 + (h)) * HTB)
#define PG8_SB(b, h) ((4 + (b) * 2 + (h)) * HTB)
#define PG8_STAGE(bufoff, gbase, voff) do { _Pragma("unroll") for (int _i = 0; _i < 2; ++_i) \
        __builtin_amdgcn_global_load_lds((const unsigned*)((const char*)(gbase) + (voff)[_i]), (PG8_LAS unsigned*)(lds + (bufoff) + ldsw + _i * 8192), 16, 0, 0); } while (0)
#define PG8_LDA(dst, b, h) do { _Pragma("unroll") for (int m = 0; m < 4; ++m) _Pragma("unroll") for (int k = 0; k < 2; ++k) dst[m][k] = *(const PG8_LAS bf16x8*)(lds + PG8_SA(b, h) + aoff + m * 2048 + k * 1024); } while (0)
#define PG8_LDB(dst, b, h) do { _Pragma("unroll") for (int n = 0; n < 2; ++n) _Pragma("unroll") for (int k = 0; k < 2; ++k) dst[n][k] = *(const PG8_LAS bf16x8*)(lds + PG8_SB(b, h) + boff + n * 2048 + k * 1024); } while (0)
#define PG8_MMA(ai, bj, At, Bt) do { __builtin_amdgcn_s_setprio(1); _Pragma("unroll") for (int m = 0; m < 4; ++m) _Pragma("unroll") for (int n = 0; n < 2; ++n) _Pragma("unroll") for (int k = 0; k < 2; ++k) \
        acc[ai][bj][m][n] = __builtin_amdgcn_mfma_f32_16x16x32_bf16(Bt[n][k], At[m][k], acc[ai][bj][m][n], 0, 0, 0); __builtin_amdgcn_s_setprio(0); } while (0)
#define PG8_WAIT_V(n) asm volatile("s_waitcnt vmcnt(" #n ")" ::: "memory")
#define PG8_WAIT_L(n) asm volatile("s_waitcnt lgkmcnt(" #n ")" ::: "memory")
#define PG8_BAR __builtin_amdgcn_s_barrier()
#define PG8_SCHED __builtin_amdgcn_sched_barrier(0)
    Unit cur, nxt; int ui = 0;
    if (!S.next(0, cur)) return;
    f32x4 acc[2][2][4][2];
    if constexpr (Epi::HAS_INIT) E.init(acc, cur, wr, wc, fr, fq);
    else {
#pragma unroll
    for (int a = 0; a < 2; ++a)
#pragma unroll
        for (int b = 0; b < 2; ++b)
#pragma unroll
            for (int m = 0; m < 4; ++m)
#pragma unroll
                for (int n = 0; n < 2; ++n) acc[a][b][m][n] = (f32x4){0.f, 0.f, 0.f, 0.f};
    }
    bf16x8 At[4][2], B0[2][2], B1[2][2];
    const char* cA = (const char*)g.A + (size_t)cur.pm * tstep; const char* cB = (const char*)g.Bt + (size_t)cur.pn * tstep;
    S.a_ready(cur);
    PG8_STAGE(PG8_SB(0, 0), cB, voffB); PG8_STAGE(PG8_SA(0, 0), cA, voffA); PG8_STAGE(PG8_SB(0, 1), cB + hstep, voffB); PG8_STAGE(PG8_SA(0, 1), cA + hstep, voffA);
    if (wr == 1) PG8_BAR;
    PG8_WAIT_V(4); PG8_BAR;
    PG8_STAGE(PG8_SB(1, 0), cB + kstep, voffB); PG8_STAGE(PG8_SA(1, 0), cA + kstep, voffA); PG8_STAGE(PG8_SB(1, 1), cB + hstep + kstep, voffB);
    PG8_WAIT_V(6); PG8_BAR;
    PG8_STAMP();
    for (;;) {
        const bool has_next = S.next(ui + 1, nxt);
        const char* nA = has_next ? (const char*)g.A + (size_t)nxt.pm * tstep : cA; const char* nB = has_next ? (const char*)g.Bt + (size_t)nxt.pn * tstep : cB;
        for (int t = 0; t < nt; t += 2) {
            const bool last = (t == nt - 2);
            const char* a1 = cA + (size_t)(t + 1) * kstep;
            const char* a2 = last ? nA : cA + (size_t)(t + 2) * kstep; const char* b2 = last ? nB : cB + (size_t)(t + 2) * kstep;
            const char* a3 = a2 + kstep; const char* b3 = b2 + kstep;
            if (last && has_next) S.a_ready(nxt);
            PG8_LDB(B0, 0, 0); PG8_SCHED; PG8_LDA(At, 0, 0); PG8_STAGE(PG8_SA(1, 1), a1 + hstep, voffA);
            PG8_WAIT_L(8); PG8_BAR; PG8_WAIT_L(0); PG8_MMA(0, 0, At, B0); PG8_BAR; PG8_SCHED;
            PG8_LDB(B1, 0, 1); PG8_STAGE(PG8_SB(0, 0), b2, voffB);
            PG8_BAR; PG8_WAIT_L(0); PG8_MMA(0, 1, At, B1); PG8_BAR;
            PG8_LDA(At, 0, 1); PG8_STAGE(PG8_SA(0, 0), a2, voffA);
            PG8_BAR; PG8_WAIT_L(0); PG8_MMA(1, 0, At, B0); PG8_BAR; PG8_SCHED;
            PG8_STAGE(PG8_SB(0, 1), b2 + hstep, voffB);
            PG8_WAIT_V(6); PG8_BAR; PG8_MMA(1, 1, At, B1); PG8_BAR;
            PG8_LDB(B0, 1, 0); PG8_SCHED; PG8_LDA(At, 1, 0); PG8_STAGE(PG8_SA(0, 1), a2 + hstep, voffA);
            PG8_WAIT_L(8); PG8_BAR; PG8_WAIT_L(0); PG8_MMA(0, 0, At, B0); PG8_BAR; PG8_SCHED;
            PG8_LDB(B1, 1, 1); PG8_STAGE(PG8_SB(1, 0), b3, voffB);
            PG8_BAR; PG8_WAIT_L(0); PG8_MMA(0, 1, At, B1); PG8_BAR;
            PG8_LDA(At, 1, 1); PG8_STAGE(PG8_SA(1, 0), a3, voffA);
            PG8_BAR; PG8_WAIT_L(0); PG8_MMA(1, 0, At, B0); PG8_BAR; PG8_SCHED;
            PG8_STAGE(PG8_SB(1, 1), b3 + hstep, voffB);
            PG8_WAIT_V(6); PG8_BAR; PG8_MMA(1, 1, At, B1); PG8_BAR;
        }
        PG8_STAMP();
        if constexpr (!Epi::AFTER_DRAIN) { E(acc, cur, wr, wc, fr, fq); S.done(cur); }
        PG8_STAMP();
        if (!has_next) break;
        if constexpr (Epi::HAS_INIT) E.init(acc, nxt, wr, wc, fr, fq);
        else {
#pragma unroll
        for (int a = 0; a < 2; ++a)
#pragma unroll
            for (int b = 0; b < 2; ++b)
#pragma unroll
                for (int m = 0; m < 4; ++m)
#pragma unroll
                    for (int n = 0; n < 2; ++n) acc[a][b][m][n] = (f32x4){0.f, 0.f, 0.f, 0.f};
        }
        cur = nxt; cA = nA; cB = nB; ++ui;
    }
    PG8_WAIT_V(0);
    if (wr == 0) PG8_BAR;
    PG8_BAR;
    if constexpr (Epi::AFTER_DRAIN) { E.fused(acc, cur, wr, wc, fr, fq, lds, wid, lane); S.done(cur); }
    PG8_STAMP();
    if (STAMP && wid == 0) { stamps[lane] = lane < nts ? (((unsigned long long)(unsigned)ts_hi << 32) | (unsigned)ts_lo) : 0ull;
        if (lane == 62) stamps[62] = rt_entry; if (lane == 63) stamps[63] = (unsigned long long)wall_clock64(); }
#undef PG8_STAMP
#undef PG8_SA
#undef PG8_SB
#undef PG8_STAGE
#undef PG8_LDA
#undef PG8_LDB
#undef PG8_MMA
#undef PG8_WAIT_V
#undef PG8_WAIT_L
#undef PG8_BAR
#undef PG8_SCHED
}
}

#define XB_TMO      128
#define XB_XCNT(j)  (256  + 64 * (j))
#define XB_XSUB(j)  (1280 + 64 * (j))
#define XB_XGEN(j)  (2304 + 64 * (j))
#define XB_TOP      3328
#define XB_TOPGEN   3392
#define XCD_BAR_WORDS 3456
#define XB_SPIN_CAP (1u << 18)
#ifndef LAS
#define LAS __attribute__((address_space(3)))
#endif

__device__ __forceinline__ unsigned xb_ld(unsigned* p)              { return __hip_atomic_load(p, __ATOMIC_RELAXED, __HIP_MEMORY_SCOPE_AGENT); }
__device__ __forceinline__ unsigned xb_add(unsigned* p, unsigned v) { return __hip_atomic_fetch_add(p, v, __ATOMIC_RELAXED, __HIP_MEMORY_SCOPE_AGENT); }
__device__ __forceinline__ unsigned xb_xcc_id() { return (unsigned)__builtin_amdgcn_s_getreg((3 << 11) | 20) & 0xFu; }
#define XB_SPIN(cond, bar) do { unsigned _sp = 0; while (cond) { __builtin_amdgcn_s_sleep(1); \
    if ((++_sp & 255u) == 0u) { if (xb_ld(&(bar)[XB_TMO])) break; if (_sp > XB_SPIN_CAP) { atomicAdd(&(bar)[XB_TMO], 1u); break; } } } } while (0)

struct XcdBarrier {
    unsigned* bar; unsigned x;
    volatile LAS unsigned* st;
};

__device__ __forceinline__ XcdBarrier xcd_barrier_post(unsigned* bar, volatile LAS unsigned* st) {
    XcdBarrier b; b.bar = bar; b.x = xb_xcc_id(); b.st = st;
    if (threadIdx.x == 0) (void)xb_add(&bar[XB_XCNT(b.x)], 1u);
    return b;
}
__device__ __forceinline__ void xcd_barrier_complete(unsigned* bar, unsigned x, unsigned& nloc, unsigned& nx) {
    const unsigned G = gridDim.x * gridDim.y * gridDim.z;
    unsigned sum, cnt, mine, sp = 0u;
    for (;;) {
        sum = 0u; cnt = 0u; mine = 0u;
#pragma unroll
        for (unsigned j = 0; j < 16; ++j) { const unsigned c = xb_ld(&bar[XB_XCNT(j)]); sum += c; cnt += (c > 0u) ? 1u : 0u; mine = (j == x) ? c : mine; }
        if (sum == G) break;
        __builtin_amdgcn_s_sleep(1);
        if ((++sp & 255u) == 0u) { if (xb_ld(&bar[XB_TMO])) break; if (sp > XB_SPIN_CAP) { atomicAdd(&bar[XB_TMO], 1u); break; } }
    }
    nloc = mine > 0u ? mine : 1u; nx = cnt > 0u ? cnt : 1u;
}

__device__ __forceinline__ void xcd_barrier(const XcdBarrier& b) {
    asm volatile("s_waitcnt vmcnt(0)" ::: "memory");
    __syncthreads();
    if (threadIdx.x == 0) {
        unsigned* bar = b.bar;
        __builtin_amdgcn_s_waitcnt(0);
        unsigned nloc = b.st[0], nx = b.st[1];
        if (nloc == 0u) { xcd_barrier_complete(bar, b.x, nloc, nx); b.st[0] = nloc; b.st[1] = nx; }
        const unsigned old = xb_add(&bar[XB_XSUB(b.x)], 1u);
        const unsigned gen = old / nloc;
        if (old + 1u == (gen + 1u) * nloc) {
            __builtin_amdgcn_fence(__ATOMIC_RELEASE, "agent");
            asm volatile("s_waitcnt vmcnt(0)" ::: "memory");
            const unsigned og = xb_add(&bar[XB_TOP], 1u);
            const unsigned tg = og / nx;
            if (og + 1u == (tg + 1u) * nx) xb_add(&bar[XB_TOPGEN], 1u);
            else XB_SPIN(xb_ld(&bar[XB_TOPGEN]) == tg, bar);
            __builtin_amdgcn_fence(__ATOMIC_ACQUIRE, "agent");
            xb_add(&bar[XB_XGEN(b.x)], 1u);
            asm volatile("s_waitcnt vmcnt(0)" ::: "memory");
        } else {
            XB_SPIN(xb_ld(&bar[XB_XGEN(b.x)]) == gen, bar);
            __builtin_amdgcn_fence(__ATOMIC_ACQUIRE, "agent");
            asm volatile("s_waitcnt vmcnt(0)" ::: "memory");
        }
    }
    __syncthreads();
}

using pg8::f32x2; using pg8::bf16_t; using pg8::bf16x8; using pg8::f32x4; using pg8::u32x4; using pg8::Unit; using pg8::cvt_pk_bf16;
typedef unsigned u32x2 __attribute__((ext_vector_type(2)));
typedef short bf16x4 __attribute__((ext_vector_type(4)));

#ifndef NLAYERS
#define NLAYERS 4
#endif
#ifndef REP_GEMM
#define REP_GEMM 0
#endif
#ifndef REP_CORE
#define REP_CORE 0
#endif
#ifndef REP_PRO
#define REP_PRO 0
#endif
#ifndef USE_SPLIT
#define USE_SPLIT 0
#endif
#ifndef REP_SYNC
#define REP_SYNC 0
#endif
#ifndef G1_PAIR
#define G1_PAIR 1
#endif
#ifndef GS_EARLY
#define GS_EARLY 0
#endif
#ifndef MULTI_LAUNCH
#define MULTI_LAUNCH 0
#endif

constexpr int M_TOK = 16896, MP = 16384, DM = 1024, DFF = 2816;
constexpr float EPS = 1e-6f;
constexpr int LDS_PHASE = 147456;
constexpr int LDS_BYTES = LDS_PHASE + 256;

constexpr size_t OUT_Y = 0;
constexpr size_t OUT_PK = (size_t)M_TOK * 1024;
constexpr size_t OUT_PV = OUT_PK + 2 * 8 * 128 * 256;
constexpr size_t OUT_PG = OUT_PV + 2 * 8 * 128 * 256;
constexpr size_t OUT_PC = OUT_PG + (size_t)8 * 16 * 128 * 128;
constexpr size_t OUT_PH = OUT_PC + 8 * 3 * 4096;
constexpr size_t OUT_SK = OUT_PH + (size_t)8 * 8 * 128 * 128;
constexpr size_t OUT_SV = OUT_SK + (size_t)2 * 128 * 128 * 256;
constexpr size_t OUT_SG = OUT_SV + (size_t)2 * 128 * 128 * 256;
constexpr size_t OUT_SC = OUT_SG + (size_t)128 * 16 * 128 * 128;
constexpr size_t OUT_SH = OUT_SC + (size_t)128 * 3 * 4096;
constexpr size_t OUT_END = OUT_SH + (size_t)128 * 8 * 128 * 128;

constexpr size_t WT_FFN_IN = 0;
constexpr size_t WT_FFN_OUT = WT_FFN_IN + (size_t)8 * 5632 * 1024 * 2;
constexpr size_t WT_SWA_IN = WT_FFN_OUT + (size_t)8 * 1024 * 2816 * 2;
constexpr size_t WT_SWA_OUT = WT_SWA_IN + (size_t)2 * 1536 * 1024 * 2;
constexpr size_t WT_GDN_IN = WT_SWA_OUT + (size_t)2 * 1024 * 1024 * 2;
constexpr size_t WT_GDN_OUT = WT_GDN_IN + (size_t)6400 * 1024 * 2;
constexpr size_t WT_HG_IN = WT_GDN_OUT + (size_t)1024 * 2048 * 2;
constexpr size_t WT_HG_OUT = WT_HG_IN + (size_t)4096 * 1024 * 2;
constexpr size_t OFF_XG = WT_HG_OUT + (size_t)1024 * 1024 * 2;
constexpr size_t OFF_HID = OFF_XG + (size_t)M_TOK * 1024 * 2;
constexpr size_t OFF_PROJ = OFF_HID + (size_t)M_TOK * 2816 * 2;
constexpr size_t OFF_O = OFF_PROJ + (size_t)M_TOK * 6400 * 2;
constexpr size_t OFF_SS = OFF_O + (size_t)M_TOK * 2048 * 2;
constexpr size_t OFF_BA = OFF_SS + (size_t)2 * M_TOK * 16 * 4;
constexpr size_t OFF_ROPE = OFF_BA + (size_t)M_TOK * 32 * 4;
constexpr size_t OFF_LB = OFF_ROPE + (size_t)2052 * 16 * 4;
constexpr size_t OFF_CNT = OFF_LB + 4096;
constexpr size_t OFF_BAR = OFF_CNT + 4096;
constexpr size_t OFF_GW = OFF_BAR + 16384;
constexpr size_t OFF_GUT = OFF_GW + (size_t)4096 * 8192 * 2;
constexpr size_t WS_END = OFF_GUT + (size_t)4096 * 8192 * 2;
constexpr size_t OFF_QN = OFF_XG;
constexpr size_t OFF_KN = OFF_QN + (size_t)2048 * 8192 * 2;
constexpr size_t OFF_ATT = OFF_KN + (size_t)2048 * 8192 * 2;
constexpr size_t OFF_GCUM = OFF_ATT + (size_t)4096 * 4096 * 2;
static_assert(OFF_GCUM + 4096 * 64 * 4 <= OFF_PROJ, "alias overflow");
constexpr size_t OFF_PART = OFF_PROJ;
constexpr size_t OFF_FZ = OFF_PROJ + (size_t)M_TOK * 4096 * 2;
static_assert(OFF_FZ + (size_t)M_TOK * 1024 * 4 <= OFF_O, "fz overflow");

struct WD { const float* src; bf16_t* dst; int K, N, Nrows, mode, tile0, pad; };
constexpr int NWD = 24;

struct Params {
    const float *x_prompt, *x_sample, *cache_k, *cache_v, *state_gdn, *state_conv, *state_hgrn;
    const float *norm_ffn, *ffn_w_in, *ffn_w_out, *norm_mix, *swa_w_in, *swa_w_out, *swa_sinks;
    const float *gdn_w_in, *gdn_conv_w, *gdn_a_log, *gdn_dt_bias, *gdn_norm, *gdn_w_out;
    const float *hgrn_w_in, *hgrn_lb, *hgrn_norm, *hgrn_w_out, *final_norm;
    float* out; unsigned char* ws;
    float inv_freq[8];
    WD wd[NWD];
    int wd_total, nprog;
    int wg_desc[14], wg_tile[14];
    unsigned char prog[80];
};

__device__ __forceinline__ int otid() { int t = threadIdx.x; asm volatile("" : "+v"(t)); return t; }
__device__ __forceinline__ int obid() { int b = blockIdx.x; asm volatile("" : "+s"(b)); return b; }

__device__ __forceinline__ float bf2f(bf16_t b) { return __uint_as_float(((unsigned)b) << 16); }
__device__ __forceinline__ float bflo(unsigned w) { return __uint_as_float(w << 16); }
__device__ __forceinline__ float bfhi(unsigned w) { return __uint_as_float(w & 0xffff0000u); }
__device__ __forceinline__ bf16_t f2bf(float f) { return (bf16_t)(cvt_pk_bf16(f, 0.f) & 0xffffu); }
__device__ __forceinline__ u32x2 pack4(f32x4 v) { u32x2 r; r.x = cvt_pk_bf16(v[0], v[1]); r.y = cvt_pk_bf16(v[2], v[3]); return r; }
__device__ __forceinline__ f32x4 unpack4(u32x2 w) { f32x4 r; r[0] = bflo(w.x); r[1] = bfhi(w.x); r[2] = bflo(w.y); r[3] = bfhi(w.y); return r; }
__device__ __forceinline__ float fast_exp(float x) { return __builtin_amdgcn_exp2f(x * 1.4426950408889634f); }
__device__ __forceinline__ float fast_log(float x) { return __builtin_amdgcn_logf(x) * 0.6931471805599453f; }
__device__ __forceinline__ float sigmoidf_(float x) { return __builtin_amdgcn_rcpf(1.0f + fast_exp(-x)); }
__device__ __forceinline__ float siluf_(float x) { return x * sigmoidf_(x); }
__device__ __forceinline__ float wave_sum(float v) {
#pragma unroll
    for (int o = 1; o < 64; o <<= 1) v += __shfl_xor(v, o);
    return v;
}
__device__ __forceinline__ float wave_max(float v) {
#pragma unroll
    for (int o = 1; o < 64; o <<= 1) v = fmaxf(v, __shfl_xor(v, o));
    return v;
}
__device__ __forceinline__ f32x4 mfma16(bf16x8 a, bf16x8 b, f32x4 c) { return __builtin_amdgcn_mfma_f32_16x16x32_bf16(a, b, c, 0, 0, 0); }
__device__ __forceinline__ bf16x8 cat8(u32x2 lo, u32x2 hi) { u32x4 w; w.x = lo.x; w.y = lo.y; w.z = hi.x; w.w = hi.y; return __builtin_bit_cast(bf16x8, w); }

__device__ __forceinline__ float row_rstd(const float* ss, int row) {
    const f32x4* sp = (const f32x4*)(ss + (size_t)row * 16);
    const f32x4 a = sp[0], b = sp[1], c = sp[2], d = sp[3];
    const f32x4 t = (a + b) + (c + d);
    return rsqrtf(((t[0] + t[1]) + (t[2] + t[3])) * (1.0f / 1024.0f) + EPS);
}
constexpr int RS_LDS_OFF = 131072;
template <class AccT> __device__ __forceinline__ void init_zero_rs(AccT& acc, const Unit& u, int wr, int wc, int fr, int fq, const float* ss, PG8_LAS float* rsb) {
#pragma unroll
    for (int a = 0; a < 2; ++a)
#pragma unroll
        for (int b = 0; b < 2; ++b)
#pragma unroll
            for (int m = 0; m < 4; ++m)
#pragma unroll
                for (int n = 0; n < 2; ++n) acc[a][b][m][n] = (f32x4){0.f, 0.f, 0.f, 0.f};
    const int t = (wr * 4 + wc) * 64 + fq * 16 + fr;
    if (t < 256) rsb[(u.idx & 1) * 256 + t] = row_rstd(ss, u.pm * 256 + t);
}
struct EpiSwiglu {
    static constexpr bool PERM = true, AFTER_DRAIN = false, HAS_INIT = false;
    bf16_t* H; const float* ss; PG8_LAS float* rsb;
    __device__ __forceinline__ void operator()(const f32x4 (&acc)[2][2][4][2], const Unit& u, int wr, int wc, int fr, int fq) const {
        const int row0 = u.pm * 256 + wr * 64 + fr, col0 = u.pn * 128 + wc * 32 + 8 * fq;
#pragma unroll
        for (int ai = 0; ai < 2; ++ai)
#pragma unroll
            for (int m = 0; m < 4; ++m) {
                const int row = row0 + ai * 128 + m * 16;
                const float rs = rsb[u.idx * 256 + ai * 128 + wr * 64 + m * 16 + fr];
                float h[8];
#pragma unroll
                for (int n = 0; n < 2; ++n)
#pragma unroll
                    for (int j = 0; j < 4; ++j) { const float g = acc[ai][0][m][n][j] * rs, up = acc[ai][1][m][n][j] * rs; h[n * 4 + j] = siluf_(g) * up; }
                u32x4 w; w.x = cvt_pk_bf16(h[0], h[1]); w.y = cvt_pk_bf16(h[2], h[3]); w.z = cvt_pk_bf16(h[4], h[5]); w.w = cvt_pk_bf16(h[6], h[7]);
                *(u32x4*)(H + (size_t)row * DFF + col0) = w;
            }
    }
};
struct EpiResid {
    static constexpr bool PERM = false, AFTER_DRAIN = false, HAS_INIT = true;
    float* X; bf16_t* XG; const float* g; float* ssn; float scale, iscale; int pm0;
    template <bool ADDX> __device__ __forceinline__ void rowgroup(const f32x4 (&a)[2][2], int row, int col0, const f32x4 (&gv)[2][2], int pn, int wc, int fq) const {
        float* xr = X + (size_t)row * 1024 + col0; bf16_t* gr = XG + (size_t)row * 1024 + col0;
        float part = 0.f;
#pragma unroll
        for (int bj = 0; bj < 2; ++bj)
#pragma unroll
            for (int n = 0; n < 2; ++n) {
                f32x4 xn = a[bj][n] * scale;
                if (ADDX) xn += *(const f32x4*)(xr + bj * 128 + n * 16);
                *(f32x4*)(xr + bj * 128 + n * 16) = xn;
                part += (xn[0] * xn[0] + xn[1] * xn[1]) + (xn[2] * xn[2] + xn[3] * xn[3]);
                *(u32x2*)(gr + bj * 128 + n * 16) = pack4(xn * gv[bj][n]);
            }
        part += __shfl_xor(part, 16); part += __shfl_xor(part, 32);
        if (fq == 0) ssn[(size_t)row * 16 + pn * 4 + wc] = part;
    }
    __device__ __forceinline__ void load_g(f32x4 (&gv)[2][2], int col0) const {
#pragma unroll
        for (int bj = 0; bj < 2; ++bj)
#pragma unroll
            for (int n = 0; n < 2; ++n) gv[bj][n] = *(const f32x4*)(g + col0 + bj * 128 + n * 16);
    }
    __device__ __forceinline__ void operator()(const f32x4 (&acc)[2][2][4][2], const Unit& u, int wr, int wc, int fr, int fq) const {
        const int row0 = (u.pm + pm0) * 256 + wr * 64 + fr, col0 = u.pn * 256 + wc * 32 + 4 * fq;
        f32x4 gv[2][2]; load_g(gv, col0);
#pragma unroll
        for (int ai = 0; ai < 2; ++ai)
#pragma unroll
            for (int m = 0; m < 4; ++m) {
                const f32x4 a[2][2] = {{acc[ai][0][m][0], acc[ai][0][m][1]}, {acc[ai][1][m][0], acc[ai][1][m][1]}};
                rowgroup<false>(a, row0 + ai * 128 + m * 16, col0, gv, u.pn, wc, fq);
            }
    }
    __device__ __forceinline__ void init(f32x4 (&acc)[2][2][4][2], const Unit& u, int wr, int wc, int fr, int fq) const {
        const int row0 = (u.pm + pm0) * 256 + wr * 64 + fr, col0 = u.pn * 256 + wc * 32 + 4 * fq;
#pragma unroll
        for (int ai = 0; ai < 2; ++ai)
#pragma unroll
            for (int m = 0; m < 4; ++m) {
                const float* xr = X + (size_t)(row0 + ai * 128 + m * 16) * 1024 + col0;
#pragma unroll
                for (int bj = 0; bj < 2; ++bj)
#pragma unroll
                    for (int n = 0; n < 2; ++n) acc[ai][bj][m][n] = *(const f32x4*)(xr + bj * 128 + n * 16) * iscale;
            }
    }
};
struct OneUnit { int pm, pn; bool have;
    __device__ __forceinline__ bool next(int i, Unit& u) const { if (i != 0 || !have) return false; u.pm = pm; u.pn = pn; u.idx = 0; return true; }
    __device__ __forceinline__ void a_ready(const Unit&) const {}
    __device__ __forceinline__ void done(const Unit&) const {} };
struct EpiSplit {
    static constexpr bool PERM = false, AFTER_DRAIN = true, HAS_INIT = false;
    EpiResid R; float* part; unsigned* cnt; int unit8, split, ns;
    __device__ __forceinline__ void fused(f32x4 (&acc)[2][2][4][2], const Unit& u, int wr, int wc, int fr, int fq, PG8_LAS unsigned char* lds, int wid, int lane) const {
        const int tid = wid * 64 + lane;
        f32x4* mine = (f32x4*)part + ((size_t)(split * 8 + unit8) * 32) * 512 + tid;
#pragma unroll
        for (int ai = 0; ai < 2; ++ai)
#pragma unroll
            for (int bj = 0; bj < 2; ++bj)
#pragma unroll
                for (int m = 0; m < 4; ++m)
#pragma unroll
                    for (int n = 0; n < 2; ++n) { *mine = acc[ai][bj][m][n]; mine += 512; asm volatile("" : "+v"(mine)); }
        asm volatile("s_waitcnt vmcnt(0)" ::: "memory");
        __syncthreads();
        PG8_LAS unsigned* flag = (PG8_LAS unsigned*)lds;
        if (tid == 0) {
            __builtin_amdgcn_fence(__ATOMIC_RELEASE, "agent"); asm volatile("s_waitcnt vmcnt(0)" ::: "memory");
            const unsigned old = __hip_atomic_fetch_add(cnt + unit8, 1u, __ATOMIC_RELAXED, __HIP_MEMORY_SCOPE_AGENT);
            if (old == (unsigned)(ns - 1)) { __builtin_amdgcn_fence(__ATOMIC_ACQUIRE, "agent"); asm volatile("s_waitcnt vmcnt(0)" ::: "memory"); }
            flag[0] = old;
        }
        __syncthreads();
        const bool last = (unsigned)__builtin_amdgcn_readfirstlane((int)flag[0]) == (unsigned)(ns - 1);
#ifndef NO_LAST
        if (last) {
            const int row0 = u.pm * 256 + wr * 64 + fr, col0 = u.pn * 256 + wc * 32 + 4 * fq;
            f32x4 gv[2][2]; R.load_g(gv, col0);
            const f32x4* base = (const f32x4*)part + ((size_t)unit8 * 32) * 512 + tid;
#pragma unroll 1
            for (int am = 0; am < 8; ++am) {
                const int ai = am >> 2, m = am & 3;
                f32x4 a[2][2];
#pragma unroll
                for (int bj = 0; bj < 2; ++bj)
#pragma unroll
                    for (int n = 0; n < 2; ++n) {
                        const f32x4* src = base + (size_t)((((ai * 2 + bj) * 4 + m) * 2 + n)) * 512;
                        f32x4 t = src[0];
#pragma unroll
                        for (int sp = 1; sp < 4; ++sp) t += src[(size_t)sp * 8 * 32 * 512];
                        a[bj][n] = t;
                    }
                R.rowgroup<true>(a, row0 + ai * 128 + m * 16, col0, gv, u.pn, wc, fq);
            }
        }
#endif
    }
};
struct EpiProj {
    static constexpr bool PERM = true, AFTER_DRAIN = false, HAS_INIT = false;
    bf16_t* P; int ld; const float* ss; int mode; const float* rope; float* side; PG8_LAS float* rsb;
    __device__ __forceinline__ void operator()(const f32x4 (&acc)[2][2][4][2], const Unit& u, int wr, int wc, int fr, int fq) const {
        const int row0 = u.pm * 256 + wr * 64 + fr, colb = u.pn * 256 + wc * 32 + 8 * fq;
#pragma unroll
        for (int ai = 0; ai < 2; ++ai)
#pragma unroll
            for (int m = 0; m < 4; ++m) {
                const int row = row0 + ai * 128 + m * 16;
                const float rs = rsb[u.idx * 256 + ai * 128 + wr * 64 + m * 16 + fr];
#pragma unroll
                for (int bj = 0; bj < 2; ++bj) {
                    const int col = colb + bj * 128;
                    f32x4 v0 = acc[ai][bj][m][0] * rs, v1 = acc[ai][bj][m][1] * rs;
                    if (mode == 0 && u.pn < 5 && (wc & 1) == 0) {
                        f32x4 p0, p1;
#pragma unroll
                        for (int j = 0; j < 4; ++j) { p0[j] = __shfl_xor(v0[j], 16); p1[j] = __shfl_xor(v1[j], 16); }
                        if (fq < 2) {
                            const int pidx = row < MP ? (row & 2047) : 2048 + ((row - MP) & 3);
                            const float* rp = rope + pidx * 16;
                            const f32x4 c0 = *(const f32x4*)rp, c1 = *(const f32x4*)(rp + 4), s0 = *(const f32x4*)(rp + 8), s1 = *(const f32x4*)(rp + 12);
                            const float sg = fq == 0 ? -1.f : 1.f;
                            v0 = v0 * c0 + p0 * s0 * sg; v1 = v1 * c1 + p1 * s1 * sg;
                        }
                    }
                    u32x4 w; w.x = cvt_pk_bf16(v0[0], v0[1]); w.y = cvt_pk_bf16(v0[2], v0[3]); w.z = cvt_pk_bf16(v1[0], v1[1]); w.w = cvt_pk_bf16(v1[2], v1[3]);
                    *(u32x4*)(P + (size_t)row * ld + col) = w;
                    if (mode == 1 && u.pn == 24 && bj == 0 && wc == 0) { float* sp = side + (size_t)row * 32 + 8 * fq; *(f32x4*)sp = v0; *(f32x4*)(sp + 4) = v1; }
                    if (mode == 2 && u.pn >= 4 && u.pn < 8) { float* sp = side + (size_t)row * 1024 + (col - 1024); *(f32x4*)sp = v0; *(f32x4*)(sp + 4) = v1; }
                }
            }
    }
};

__device__ __forceinline__ void convert_weights(const Params& p, unsigned char* shm, int grp, int wk, int nwk) {
    const int tid = otid();
    float* tile = (float*)shm;
    const int dlo = p.wg_desc[grp], dhi = p.wg_desc[grp + 1];
    __syncthreads();
    for (int it = p.wg_tile[grp] + wk; it < p.wg_tile[grp + 1]; it += nwk) {
        int d = dlo;
#pragma unroll 1
        while (d + 1 < dhi && it >= p.wd[d + 1].tile0) ++d;
        const float* src = p.wd[d].src; bf16_t* dst = p.wd[d].dst; const int K = p.wd[d].K, N = p.wd[d].N, mode = p.wd[d].mode, ntn = p.wd[d].Nrows >> 6;
        const int t = it - p.wd[d].tile0, k0 = (t / ntn) * 128, n0 = (t % ntn) * 64;
        {
            const int c = tid & 63, kr = tid >> 6; const int np = n0 + c; int col; bool ok = true;
            if (mode == 1) { const int pn = np >> 8, w = np & 255; col = (w >> 7) * DFF + pn * 128 + (w & 127); } else { col = np; ok = np < N; }
#pragma unroll
            for (int i = 0; i < 16; ++i) { const int k = kr + 8 * i; tile[k * 65 + c] = ok ? src[(size_t)(k0 + k) * N + col] : 0.f; }
        }
        __syncthreads();
#pragma unroll
        for (int i = 0; i < 2; ++i) {
            const int e = tid + 512 * i, nr = e >> 4, ch = e & 15;
            const float* sv = tile + (ch * 8) * 65 + nr;
            u32x4 o; o.x = cvt_pk_bf16(sv[0], sv[65]); o.y = cvt_pk_bf16(sv[2 * 65], sv[3 * 65]); o.z = cvt_pk_bf16(sv[4 * 65], sv[5 * 65]); o.w = cvt_pk_bf16(sv[6 * 65], sv[7 * 65]);
            *(u32x4*)(dst + (size_t)(n0 + nr) * K + k0 + ch * 8) = o;
        }
        __syncthreads();
    }
}

__device__ __forceinline__ void ph_prologue(const Params& p, unsigned char* shm) {
    const int tid = otid(), lane = tid & 63, wave = tid >> 6;
    const int gt = obid() * 512 + tid, ngt = gridDim.x * 512;
    float* SS = (float*)(p.ws + OFF_SS);
    if (gt < 96) ((unsigned*)(p.ws + OFF_CNT))[gt] = 0u;
    float* rope = (float*)(p.ws + OFF_ROPE);
    for (int i = gt; i < 2052 * 8; i += ngt) {
        const int pidx = i >> 3, k = i & 7; const int pos = pidx < 2048 ? pidx : 8192 + (pidx - 2048);
        const double ang = (double)pos * (double)p.inv_freq[k];
        double rev = ang * 0.15915494309189535; rev -= __builtin_rint(rev);
        const float a = (float)(rev * 6.283185307179586);
        rope[pidx * 16 + k] = __cosf(a); rope[pidx * 16 + 8 + k] = __sinf(a);
    }
    float* LB = (float*)(p.ws + OFF_LB);
    for (int i = gt; i < 1024; i += ngt) {
        const float l0 = p.hgrn_lb[i], l1 = p.hgrn_lb[1024 + i], l2 = p.hgrn_lb[2048 + i], l3 = p.hgrn_lb[3072 + i];
        const float mx = fmaxf(fmaxf(l0, l1), fmaxf(l2, l3));
        const float e0 = expf(l0 - mx), e1 = expf(l1 - mx), e2 = expf(l2 - mx), e3 = expf(l3 - mx);
        LB[i] = (e1 + e2) / (e0 + e1 + e2 + e3);
    }
    float* X = p.out; bf16_t* XG = (bf16_t*)(p.ws + OFF_XG);
    for (int r = obid() * 8 + wave; r < M_TOK; r += gridDim.x * 8) {
        const float* src = r < MP ? p.x_prompt + (size_t)r * 1024 : p.x_sample + (size_t)(r - MP) * 1024;
        float s = 0.f;
#pragma unroll
        for (int j = 0; j < 4; ++j) {
            const int c = lane * 4 + 256 * j;
            const f32x4 v = *(const f32x4*)(src + c), g = *(const f32x4*)(p.norm_ffn + c);
            *(f32x4*)(X + (size_t)r * 1024 + c) = v;
            s += (v[0] * v[0] + v[1] * v[1]) + (v[2] * v[2] + v[3] * v[3]);
            *(u32x2*)(XG + (size_t)r * 1024 + c) = pack4(v * g);
        }
        s = wave_sum(s);
        if (lane < 16) SS[(size_t)r * 16 + lane] = lane == 0 ? s : 0.f;
    }
    convert_weights(p, shm, 0, obid(), gridDim.x);
}

__device__ __forceinline__ void ph_final(const Params& p) {
    const int lane = otid() & 63, wave = otid() >> 6;
    const float* ss = (const float*)(p.ws + OFF_SS);
    for (int r = obid() * 8 + wave; r < M_TOK; r += gridDim.x * 8) {
        const float rs = row_rstd(ss, r);
#pragma unroll
        for (int j = 0; j < 4; ++j) {
            const int c = lane * 4 + 256 * j;
            float* xp = p.out + (size_t)r * 1024 + c;
            *(f32x4*)xp = *(const f32x4*)xp * rs * *(const f32x4*)(p.final_norm + c);
        }
    }
}

__device__ __forceinline__ void swa_prompt_item(const Params& p, unsigned char* shm, int j, int item) {
    const int tid = otid(), lane = tid & 63, wave = tid >> 6, fr = lane & 15, fq = lane >> 4;
    const int n = item & 15, kvh = (item >> 4) & 3, b = item >> 6;
    const bf16_t* P = (const bf16_t*)(p.ws + OFF_PROJ);
    bf16_t* Ob = (bf16_t*)(p.ws + OFF_O);
    bf16_t* Ks = (bf16_t*)shm;
    bf16_t* Vt = (bf16_t*)(shm + 36864);
    const size_t rowbase = (size_t)b * 2048;
    const int g = wave >> 1, qh = wave & 1, h = kvh * 4 + g;
    bf16x8 qfr[4][2];
    {
        u32x4 kvr[4], vvr[4];
#pragma unroll
        for (int k = 0; k < 4; ++k) {
            const int e = tid + 512 * k, key = e >> 3, ch = e & 7; const int pos = (n - 1) * 128 + key;
            kvr[k] = (u32x4){0u, 0u, 0u, 0u}; vvr[k] = (u32x4){0u, 0u, 0u, 0u};
            if (pos >= 0) { const bf16_t* src = P + (rowbase + pos) * 1536; kvr[k] = *(const u32x4*)(src + 1024 + kvh * 64 + ch * 8); vvr[k] = *(const u32x4*)(src + 1280 + kvh * 64 + ch * 8); }
        }
#pragma unroll
        for (int ti = 0; ti < 4; ++ti) {
            const bf16_t* qsrc = P + (rowbase + n * 128 + qh * 64 + ti * 16 + fr) * 1536 + h * 64 + fq * 8;
            qfr[ti][0] = *(const bf16x8*)qsrc; qfr[ti][1] = *(const bf16x8*)(qsrc + 32);
        }
#pragma unroll
        for (int k = 0; k < 4; ++k) {
            const int e = tid + 512 * k, key = e >> 3, ch = e & 7;
            const u32x4 kv = kvr[k], vv = vvr[k];
            *(u32x4*)(Ks + key * 72 + ch * 8) = kv;
#pragma unroll
            for (int q = 0; q < 4; ++q) { Vt[(ch * 8 + 2 * q) * 264 + key] = (bf16_t)(vv[q] & 0xffffu); Vt[(ch * 8 + 2 * q + 1) * 264 + key] = (bf16_t)(vv[q] >> 16); }
            if (n == 15 && key >= 128) {
                const size_t o = ((size_t)((j * 8 + b) * 128 + (key - 128))) * 256 + kvh * 64 + ch * 8;
                float* ok = p.out + OUT_PK + o; float* ov = p.out + OUT_PV + o;
#pragma unroll
                for (int q = 0; q < 4; ++q) { ok[2 * q] = bflo(kv[q]); ok[2 * q + 1] = bfhi(kv[q]); ov[2 * q] = bflo(vv[q]); ov[2 * q + 1] = bfhi(vv[q]); }
            }
        }
    }
    __syncthreads();
    const float sink = p.swa_sinks[j * 16 + h];
#pragma unroll
    for (int ti = 0; ti < 4; ++ti) {
        const int q0 = qh * 64 + ti * 16, T0 = q0 >> 4;
        const bf16x8 qf0 = qfr[ti][0], qf1 = qfr[ti][1];
        f32x4 s[9];
#pragma unroll
        for (int kt = 0; kt < 9; ++kt) {
            const bf16_t* kp = Ks + ((T0 + kt) * 16 + fr) * 72 + fq * 8;
            f32x4 a = {0.f, 0.f, 0.f, 0.f};
            a = mfma16(*(const bf16x8*)kp, qf0, a); a = mfma16(*(const bf16x8*)(kp + 32), qf1, a);
            s[kt] = a;
        }
        const int ql = q0 + fr; float mx = -1e30f;
#pragma unroll
        for (int kt = 0; kt < 9; ++kt)
#pragma unroll
            for (int jj = 0; jj < 4; ++jj) {
                const int kl = (T0 + kt) * 16 + 4 * fq + jj;
                const bool valid = (kl > ql) && (kl <= ql + 128) && (n > 0 || kl >= 128);
                const float v = valid ? s[kt][jj] * 0.125f : -1e30f; s[kt][jj] = v; mx = fmaxf(mx, v);
            }
        mx = fmaxf(mx, __shfl_xor(mx, 16)); mx = fmaxf(mx, __shfl_xor(mx, 32)); mx = fmaxf(mx, sink);
        float l = 0.f;
#pragma unroll
        for (int kt = 0; kt < 9; ++kt)
#pragma unroll
            for (int jj = 0; jj < 4; ++jj) { const float e = fast_exp(s[kt][jj] - mx); s[kt][jj] = e; l += e; }
        l += __shfl_xor(l, 16); l += __shfl_xor(l, 32); l += fast_exp(sink - mx);
        bf16x8 pf[5];
#pragma unroll
        for (int u = 0; u < 4; ++u) pf[u] = cat8(pack4(s[2 * u]), pack4(s[2 * u + 1]));
        { const u32x2 z = {0u, 0u}; pf[4] = cat8(pack4(s[8]), z); }
        f32x4 o[4];
#pragma unroll
        for (int td = 0; td < 4; ++td) {
            f32x4 a = {0.f, 0.f, 0.f, 0.f};
#pragma unroll
            for (int u = 0; u < 5; ++u) {
                const bf16_t* vp = Vt + (td * 16 + fr) * 264 + (T0 + 2 * u) * 16 + 4 * fq;
                const u32x2 lo = *(const u32x2*)vp; u32x2 hi = {0u, 0u};
                if (u < 4) hi = *(const u32x2*)(vp + 16);
                a = mfma16(cat8(lo, hi), pf[u], a);
            }
            o[td] = a;
        }
        const float inv = 1.0f / l;
        bf16_t* op = Ob + (rowbase + n * 128 + q0 + fr) * 1024 + h * 64 + 4 * fq;
#pragma unroll
        for (int td = 0; td < 4; ++td) *(u32x2*)(op + td * 16) = pack4(o[td] * inv);
    }
    __syncthreads();
}

__device__ __forceinline__ void swa_sample_item(const Params& p, unsigned char* shm, int j, int item) {
    const int tid = otid(), lane = tid & 63, wave = tid >> 6, fr = lane & 15, fq = lane >> 4;
    const int kvh = item & 3, b = item >> 2;
    const bf16_t* P = (const bf16_t*)(p.ws + OFF_PROJ);
    bf16_t* Ob = (bf16_t*)(p.ws + OFF_O);
    bf16_t* Ks = (bf16_t*)shm;
    bf16_t* Vt = Ks + 144 * 72;
    const size_t cb = ((size_t)(j * 128 + b) * 128) * 256 + kvh * 64;
    const float* ck = p.cache_k + cb; const float* cv = p.cache_v + cb;
    float* ok = p.out + OUT_SK + cb; float* ov = p.out + OUT_SV + cb;
    const int tq = fr & 3, gq = fr >> 2;
    bf16x8 qf0, qf1;
    { const bf16_t* qsrc = P + (size_t)(MP + b * 4 + tq) * 1536 + (kvh * 4 + gq) * 64 + fq * 8; qf0 = *(const bf16x8*)qsrc; qf1 = *(const bf16x8*)(qsrc + 32); }
    for (int e0 = tid; e0 < 148 * 64; e0 += 2048) {
        float kx[4], vx[4];
#pragma unroll
        for (int k = 0; k < 4; ++k) {
            const int e = e0 + 512 * k, row = e >> 6, d = e & 63; kx[k] = 0.f; vx[k] = 0.f;
            if (row < 128) { kx[k] = ck[row * 256 + d]; vx[k] = cv[row * 256 + d]; }
            else if (row < 132) { const bf16_t* src = P + (size_t)(MP + b * 4 + row - 128) * 1536; kx[k] = bf2f(src[1024 + kvh * 64 + d]); vx[k] = bf2f(src[1280 + kvh * 64 + d]); }
        }
#pragma unroll
        for (int k = 0; k < 4; ++k) {
            const int e = e0 + 512 * k, row = e >> 6, d = e & 63;
            if (row < 148) {
                if (row < 144) Ks[row * 72 + d] = f2bf(kx[k]);
                Vt[d * 148 + row] = f2bf(vx[k]);
                if (row >= 4 && row < 132) { ok[(row - 4) * 256 + d] = kx[k]; ov[(row - 4) * 256 + d] = vx[k]; }
            }
        }
    }
    __syncthreads();
    if (wave == 0) {
        const float sink = p.swa_sinks[j * 16 + kvh * 4 + gq];
        f32x4 s[9];
#pragma unroll
        for (int kt = 0; kt < 9; ++kt) {
            const bf16_t* kp = Ks + (kt * 16 + fr) * 72 + fq * 8;
            f32x4 a = {0.f, 0.f, 0.f, 0.f};
            a = mfma16(*(const bf16x8*)kp, qf0, a); a = mfma16(*(const bf16x8*)(kp + 32), qf1, a);
            s[kt] = a;
        }
        float mx = -1e30f;
#pragma unroll
        for (int kt = 0; kt < 9; ++kt)
#pragma unroll
            for (int jj = 0; jj < 4; ++jj) {
                const int kl = kt * 16 + 4 * fq + jj;
                const bool valid = kl >= tq + 1 && kl <= tq + 128;
                const float v = valid ? s[kt][jj] * 0.125f : -1e30f; s[kt][jj] = v; mx = fmaxf(mx, v);
            }
        mx = fmaxf(mx, __shfl_xor(mx, 16)); mx = fmaxf(mx, __shfl_xor(mx, 32)); mx = fmaxf(mx, sink);
        float l = 0.f;
#pragma unroll
        for (int kt = 0; kt < 9; ++kt)
#pragma unroll
            for (int jj = 0; jj < 4; ++jj) { const float e = fast_exp(s[kt][jj] - mx); s[kt][jj] = e; l += e; }
        l += __shfl_xor(l, 16); l += __shfl_xor(l, 32); l += fast_exp(sink - mx);
        bf16x8 pf[5];
#pragma unroll
        for (int u = 0; u < 4; ++u) pf[u] = cat8(pack4(s[2 * u]), pack4(s[2 * u + 1]));
        { const u32x2 z = {0u, 0u}; pf[4] = cat8(pack4(s[8]), z); }
        const float inv = 1.0f / l;
        bf16_t* op = Ob + (size_t)(MP + b * 4 + tq) * 1024 + (kvh * 4 + gq) * 64 + 4 * fq;
#pragma unroll
        for (int td = 0; td < 4; ++td) {
            f32x4 a = {0.f, 0.f, 0.f, 0.f};
#pragma unroll
            for (int u = 0; u < 5; ++u) {
                const bf16_t* vp = Vt + (td * 16 + fr) * 148 + (2 * u) * 16 + 4 * fq;
                const u32x2 lo = *(const u32x2*)vp; u32x2 hi = {0u, 0u};
                if (u < 4) hi = *(const u32x2*)(vp + 16);
                a = mfma16(cat8(lo, hi), pf[u], a);
            }
            *(u32x2*)(op + td * 16) = pack4(a * inv);
        }
    }
    __syncthreads();
}

__device__ __forceinline__ void gdn_g1_unit(const Params& p, unsigned char* shm, int unit) {
    const int tid = otid(), lane = tid & 63, wave = tid >> 6, fr = lane & 15, fq = lane >> 4;
    const int c = unit & 31, vh = (unit >> 5) & 15, b = unit >> 9, hq = vh >> 1;
    const int R0 = b * 2048 + c * 64;
    const bf16_t* P = (const bf16_t*)(p.ws + OFF_PROJ);
    const float* BA = (const float*)(p.ws + OFF_BA);
    bf16_t* qn = (bf16_t*)shm;
    bf16_t* kn = qn + 64 * 136;
    bf16_t* kbgT = kn + 64 * 136;
    bf16_t* vbT = kbgT + 128 * 72;
    float* Af = (float*)(vbT + 128 * 72);
    bf16_t* Tb = (bf16_t*)(Af + 64 * 68);
    float* gc = (float*)(Tb + 64 * 72);
    float* bt = gc + 64;
    float* GCUM = (float*)(p.ws + OFF_GCUM);
    {
        const int un = unit + (int)gridDim.x;
        if (un < 4096 && tid < 466) {
            const int cn = un & 31, vhn = (un >> 5) & 15, bn = un >> 9, hqn = vhn >> 1, Rn = bn * 2048 + cn * 64;
            const char* a = nullptr;
            if (tid < 402) { const int r = tid / 6, sgl = tid - r * 6, seg = sgl >> 1, row = Rn - 3 + r;
                if (row >= bn * 2048) a = (const char*)(P + (size_t)row * 6400 + (seg == 0 ? hqn * 128 : (seg == 1 ? 1024 + hqn * 128 : 2048 + vhn * 128)) + (sgl & 1) * 64); }
            else a = (const char*)(BA + (size_t)(Rn + tid - 402) * 32);
            if (a) (void)*(const volatile float*)a;
        }
    }
    if (wave == 0) {
        const int r = R0 + lane;
        const float a = BA[(size_t)r * 32 + 16 + vh] + p.gdn_dt_bias[vh];
        const float sp = a > 20.f ? a : log1pf(expf(a));
        const float g = -expf(p.gdn_a_log[vh]) * sp;
        const float be = 1.0f / (1.0f + fast_exp(-BA[(size_t)r * 32 + vh]));
        float cs = g;
#pragma unroll
        for (int o = 1; o < 64; o <<= 1) { const float t = __shfl_up(cs, o); if (lane >= o) cs += t; }
        gc[lane] = cs; bt[lane] = be; GCUM[(size_t)unit * 64 + lane] = cs;
    }
    __syncthreads();
    {
        const int i = tid >> 3, cb = tid & 7, t = c * 64 + i;
        const float be = bt[i], eg = fast_exp(gc[i]);
        const int uq = (b * 8 + hq) * 32 + c;
#pragma unroll
        for (int op = 0; op < 3; ++op) {
            const int col = op == 0 ? hq * 128 + cb * 16 : (op == 1 ? 1024 + hq * 128 + cb * 16 : 2048 + vh * 128 + cb * 16);
            float acc[16];
#pragma unroll
            for (int e = 0; e < 16; ++e) acc[e] = 0.f;
#pragma unroll
            for (int jj = 0; jj < 4; ++jj) {
                const int tt = t - 3 + jj;
                if (tt >= 0) {
                    const bf16_t* src = P + (size_t)(b * 2048 + tt) * 6400 + col;
                    const u32x4 xa = *(const u32x4*)src, xb = *(const u32x4*)(src + 8);
                    const float* w = p.gdn_conv_w + jj * 4096 + col;
                    float x[16];
#pragma unroll
                    for (int q = 0; q < 4; ++q) { x[2 * q] = bflo(xa[q]); x[2 * q + 1] = bfhi(xa[q]); x[8 + 2 * q] = bflo(xb[q]); x[8 + 2 * q + 1] = bfhi(xb[q]); }
#pragma unroll
                    for (int q = 0; q < 4; ++q) { const f32x4 wv = *(const f32x4*)(w + 4 * q);
#pragma unroll
                        for (int e = 0; e < 4; ++e) acc[4 * q + e] += x[4 * q + e] * wv[e]; }
                    if (jj == 3 && c == 31 && i >= 61 && (op == 2 || (vh & 1) == 0)) {
                        float* pc = p.out + OUT_PC + (size_t)(b * 3 + (i - 61)) * 4096 + col;
#pragma unroll
                        for (int q = 0; q < 4; ++q) { f32x4 o; o[0] = x[4 * q]; o[1] = x[4 * q + 1]; o[2] = x[4 * q + 2]; o[3] = x[4 * q + 3]; *(f32x4*)(pc + 4 * q) = o; }
                    }
                }
            }
#pragma unroll
            for (int e = 0; e < 16; ++e) acc[e] = siluf_(acc[e]);
            if (op < 2) {
                float ss = 0.f;
#pragma unroll
                for (int e = 0; e < 16; ++e) ss += acc[e] * acc[e];
                ss += __shfl_xor(ss, 1); ss += __shfl_xor(ss, 2); ss += __shfl_xor(ss, 4);
                float rn = rsqrtf(ss + 1e-6f); if (op == 0) rn *= 0.08838834764831845f;
#pragma unroll
                for (int e = 0; e < 16; ++e) acc[e] *= rn;
                u32x4 w0, w1;
#pragma unroll
                for (int q = 0; q < 4; ++q) { w0[q] = cvt_pk_bf16(acc[2 * q], acc[2 * q + 1]); w1[q] = cvt_pk_bf16(acc[8 + 2 * q], acc[8 + 2 * q + 1]); }
                bf16_t* ld = (op == 0 ? qn : kn) + i * 136 + cb * 16;
                *(u32x4*)ld = w0; *(u32x4*)(ld + 8) = w1;
                if ((vh & 1) == 0) {
                    bf16_t* gd = (bf16_t*)(p.ws + (op == 0 ? OFF_QN : OFF_KN)) + (size_t)uq * 8192 + i * 128 + cb * 16;
                    *(u32x4*)gd = w0; *(u32x4*)(gd + 8) = w1;
                }
                if (op == 1) {
                    const float f = be * eg;
#pragma unroll
                    for (int e = 0; e < 16; ++e) kbgT[(cb * 16 + e) * 72 + i] = f2bf(acc[e] * f);
                }
            } else {
#pragma unroll
                for (int e = 0; e < 16; ++e) vbT[(cb * 16 + e) * 72 + i] = f2bf(acc[e] * be);
            }
        }
    }
    __syncthreads();
    {
        const int which = wave >> 2, ti = wave & 3; const bf16_t* bsrc = which ? qn : kn;
        bf16x8 bfr[4];
#pragma unroll
        for (int ks = 0; ks < 4; ++ks) bfr[ks] = *(const bf16x8*)(bsrc + (ti * 16 + fr) * 136 + ks * 32 + fq * 8);
        const int i = ti * 16 + fr; const float gi = gc[i], bi = bt[i];
        bf16_t* ATT = (bf16_t*)(p.ws + OFF_ATT) + (size_t)unit * 4096;
#pragma unroll
        for (int tj = 0; tj < 4; ++tj) {
            f32x4 a = {0.f, 0.f, 0.f, 0.f};
            if (tj <= ti) {
#pragma unroll
                for (int ks = 0; ks < 4; ++ks) a = mfma16(*(const bf16x8*)(kn + (tj * 16 + fr) * 136 + ks * 32 + fq * 8), bfr[ks], a);
            }
            f32x4 r;
#pragma unroll
            for (int jj = 0; jj < 4; ++jj) {
                const int jx = tj * 16 + 4 * fq + jj;
                const float dec = fast_exp(fminf(gi - gc[jx], 0.f));
                r[jj] = which ? (jx <= i ? a[jj] * dec : 0.f) : (jx < i ? a[jj] * dec * bi : 0.f);
            }
            if (which == 0) *(f32x4*)(Af + i * 68 + tj * 16 + 4 * fq) = r;
            else *(u32x2*)(ATT + i * 64 + tj * 16 + 4 * fq) = pack4(r);
        }
    }
    __syncthreads();
    if (wave == 0) {
        float ar[64];
#pragma unroll
        for (int i = 0; i < 64; ++i) ar[i] = Af[i * 68 + lane];
        float t[64];
#pragma unroll
        for (int i = 0; i < 64; ++i) {
            float a0 = (i == lane) ? 1.f : 0.f, a1 = 0.f, a2 = 0.f, a3 = 0.f;
#pragma unroll
            for (int j = 0; j < i; ++j) {
                const float sv = __int_as_float(__builtin_amdgcn_readlane(__float_as_int(ar[i]), j));
                if ((j & 3) == 0) a0 -= sv * t[j]; else if ((j & 3) == 1) a1 -= sv * t[j]; else if ((j & 3) == 2) a2 -= sv * t[j]; else a3 -= sv * t[j];
            }
            t[i] = (a0 + a1) + (a2 + a3);
        }
#pragma unroll
        for (int i = 0; i < 64; ++i) Tb[i * 72 + lane] = f2bf(t[i]);
    }
    __syncthreads();
    {
        const int td = wave;
        const bf16x8 a0 = *(const bf16x8*)(kbgT + (td * 16 + fr) * 72 + fq * 8), a1 = *(const bf16x8*)(kbgT + (td * 16 + fr) * 72 + 32 + fq * 8);
        const bf16x8 v0 = *(const bf16x8*)(vbT + (td * 16 + fr) * 72 + fq * 8), v1 = *(const bf16x8*)(vbT + (td * 16 + fr) * 72 + 32 + fq * 8);
        bf16_t* W = (bf16_t*)(p.ws + OFF_GW) + (size_t)unit * 8192; bf16_t* UT = (bf16_t*)(p.ws + OFF_GUT) + (size_t)unit * 8192;
#pragma unroll
        for (int ti = 0; ti < 4; ++ti) {
            const bf16x8 t0 = *(const bf16x8*)(Tb + (ti * 16 + fr) * 72 + fq * 8), t1 = *(const bf16x8*)(Tb + (ti * 16 + fr) * 72 + 32 + fq * 8);
            f32x4 w = {0.f, 0.f, 0.f, 0.f}; w = mfma16(a0, t0, w); w = mfma16(a1, t1, w);
            *(u32x2*)(W + (ti * 16 + fr) * 128 + td * 16 + 4 * fq) = pack4(w);
            f32x4 uu = {0.f, 0.f, 0.f, 0.f}; uu = mfma16(t0, v0, uu); uu = mfma16(t1, v1, uu);
            *(u32x2*)(UT + (td * 16 + fr) * 64 + ti * 16 + 4 * fq) = pack4(uu);
        }
    }
    __syncthreads();
}

__device__ __forceinline__ void gdn_g1_pair(const Params& p, unsigned char* shm, int pair) {
    const int tid = otid(), lane = tid & 63, wave = tid >> 6, fr = lane & 15, fq = lane >> 4;
    const int c = pair & 31, hq = (pair >> 5) & 7, b = pair >> 8;
    const int R0 = b * 2048 + c * 64;
    const bf16_t* P = (const bf16_t*)(p.ws + OFF_PROJ);
    const float* BA = (const float*)(p.ws + OFF_BA);
    bf16_t* qn = (bf16_t*)shm;
    bf16_t* kn = qn + 64 * 136;
    bf16_t* kbgT = kn + 64 * 136;
    bf16_t* vbT = kbgT + 2 * 128 * 72;
    float* Af = (float*)(vbT + 2 * 128 * 72);
    float* gc = Af + 2 * 64 * 68;
    float* bt = gc + 128;
    float* GCUM = (float*)(p.ws + OFF_GCUM);
    float pf0 = 0.f, pf1 = 0.f;
    {
        const int pn = pair + (int)gridDim.x;
        if (pn < 2048) {
            const int cn = pn & 31, hqn = (pn >> 5) & 7, bn = pn >> 8, Rn = bn * 2048 + cn * 64;
#pragma unroll
            for (int kk2 = 0; kk2 < 2; ++kk2) {
                const int k = tid + 512 * kk2;
                const char* a = nullptr;
                if (k < 536) { const int r = k >> 3, sg = k & 7, row = Rn - 3 + r;
                    if (row >= bn * 2048) a = (const char*)(P + (size_t)row * 6400 + (sg < 2 ? hqn * 128 + sg * 64 : (sg < 4 ? 1024 + hqn * 128 + (sg - 2) * 64 : 2048 + hqn * 256 + (sg - 4) * 64))); }
                else if (k < 600) a = (const char*)(BA + (size_t)(Rn + k - 536) * 32);
                if (a) { const float v = *(const volatile float*)a; if (kk2 == 0) pf0 = v; else pf1 = v; }
            }
        }
    }
    if (wave < 2) {
        const int vh = 2 * hq + wave, r = R0 + lane, unit = (b * 16 + vh) * 32 + c;
        const float a = BA[(size_t)r * 32 + 16 + vh] + p.gdn_dt_bias[vh];
        const float sp = a > 20.f ? a : log1pf(expf(a));
        const float g = -expf(p.gdn_a_log[vh]) * sp;
        const float be = 1.0f / (1.0f + fast_exp(-BA[(size_t)r * 32 + vh]));
        float cs = g;
#pragma unroll
        for (int o = 1; o < 64; o <<= 1) { const float t = __shfl_up(cs, o); if (lane >= o) cs += t; }
        gc[wave * 64 + lane] = cs; bt[wave * 64 + lane] = be; GCUM[(size_t)unit * 64 + lane] = cs;
    }
    __syncthreads();
    {
        const int rg = wave, i0 = rg * 8, t0 = c * 64 + i0;
        const int uq = (b * 8 + hq) * 32 + c;
        float f0[8], f1[8], e0[8], e1[8];
#pragma unroll
        for (int e = 0; e < 8; ++e) { e0[e] = bt[i0 + e]; e1[e] = bt[64 + i0 + e]; f0[e] = e0[e] * fast_exp(gc[i0 + e]); f1[e] = e1[e] * fast_exp(gc[64 + i0 + e]); }
#pragma unroll
        for (int op = 0; op < 4; ++op) {
            const int col = (op == 0 ? hq * 128 : (op == 1 ? 1024 + hq * 128 : 2048 + (2 * hq + (op - 2)) * 128)) + 2 * lane;
            unsigned xr[11];
#pragma unroll
            for (int rr = 0; rr < 11; ++rr) { const int tt = t0 - 3 + rr; xr[rr] = tt >= 0 ? *(const unsigned*)(P + (size_t)(b * 2048 + tt) * 6400 + col) : 0u; }
            f32x2 wv[4];
#pragma unroll
            for (int jj = 0; jj < 4; ++jj) wv[jj] = *(const f32x2*)(p.gdn_conv_w + jj * 4096 + col);
            if (c == 31 && rg == 7) {
#pragma unroll
                for (int e = 5; e < 8; ++e) { f32x2 o; o.x = bflo(xr[e + 3]); o.y = bfhi(xr[e + 3]); *(f32x2*)(p.out + OUT_PC + (size_t)(b * 3 + (e - 5)) * 4096 + col) = o; }
            }
            float a0[8], a1[8];
#pragma unroll
            for (int e = 0; e < 8; ++e) {
                float s0 = 0.f, s1 = 0.f;
#pragma unroll
                for (int jj = 0; jj < 4; ++jj) { s0 += bflo(xr[e + jj]) * wv[jj].x; s1 += bfhi(xr[e + jj]) * wv[jj].y; }
                a0[e] = siluf_(s0); a1[e] = siluf_(s1);
            }
            if (op < 2) {
#pragma unroll
                for (int e = 0; e < 8; ++e) {
                    float rn = rsqrtf(wave_sum(a0[e] * a0[e] + a1[e] * a1[e]) + 1e-6f); if (op == 0) rn *= 0.08838834764831845f;
                    a0[e] *= rn; a1[e] *= rn;
                    const unsigned w = cvt_pk_bf16(a0[e], a1[e]);
                    *(unsigned*)((op == 0 ? qn : kn) + (i0 + e) * 136 + 2 * lane) = w;
                    *(unsigned*)((bf16_t*)(p.ws + (op == 0 ? OFF_QN : OFF_KN)) + (size_t)uq * 8192 + (i0 + e) * 128 + 2 * lane) = w;
                }
                if (op == 1) {
                    u32x4 k00, k01, k10, k11;
#pragma unroll
                    for (int q = 0; q < 4; ++q) {
                        k00[q] = cvt_pk_bf16(a0[2 * q] * f0[2 * q], a0[2 * q + 1] * f0[2 * q + 1]); k01[q] = cvt_pk_bf16(a1[2 * q] * f0[2 * q], a1[2 * q + 1] * f0[2 * q + 1]);
                        k10[q] = cvt_pk_bf16(a0[2 * q] * f1[2 * q], a0[2 * q + 1] * f1[2 * q + 1]); k11[q] = cvt_pk_bf16(a1[2 * q] * f1[2 * q], a1[2 * q + 1] * f1[2 * q + 1]);
                    }
                    *(u32x4*)(kbgT + (2 * lane) * 72 + i0) = k00; *(u32x4*)(kbgT + (2 * lane + 1) * 72 + i0) = k01;
                    *(u32x4*)(kbgT + 128 * 72 + (2 * lane) * 72 + i0) = k10; *(u32x4*)(kbgT + 128 * 72 + (2 * lane + 1) * 72 + i0) = k11;
                }
            } else {
                bf16_t* vd = vbT + (op - 2) * 128 * 72;
                u32x4 v0w, v1w;
#pragma unroll
                for (int q = 0; q < 4; ++q) {
                    const float b0 = op == 2 ? e0[2 * q] : e1[2 * q], b1 = op == 2 ? e0[2 * q + 1] : e1[2 * q + 1];
                    v0w[q] = cvt_pk_bf16(a0[2 * q] * b0, a0[2 * q + 1] * b1); v1w[q] = cvt_pk_bf16(a1[2 * q] * b0, a1[2 * q + 1] * b1);
                }
                *(u32x4*)(vd + (2 * lane) * 72 + i0) = v0w; *(u32x4*)(vd + (2 * lane + 1) * 72 + i0) = v1w;
            }
        }
    }
    __syncthreads();
    {
        const int which = wave >> 2, ti = wave & 3; const bf16_t* bsrc = which ? qn : kn;
        bf16x8 bfr[4];
#pragma unroll
        for (int ks = 0; ks < 4; ++ks) bfr[ks] = *(const bf16x8*)(bsrc + (ti * 16 + fr) * 136 + ks * 32 + fq * 8);
        const int i = ti * 16 + fr;
        const float gi0 = gc[i], gi1 = gc[64 + i], bi0 = bt[i], bi1 = bt[64 + i];
        bf16_t* ATT0 = (bf16_t*)(p.ws + OFF_ATT) + (size_t)((b * 16 + 2 * hq) * 32 + c) * 4096;
        bf16_t* ATT1 = ATT0 + (size_t)32 * 4096;
#pragma unroll
        for (int tj = 0; tj < 4; ++tj) {
            f32x4 a = {0.f, 0.f, 0.f, 0.f};
            if (tj <= ti) {
#pragma unroll
                for (int ks = 0; ks < 4; ++ks) a = mfma16(*(const bf16x8*)(kn + (tj * 16 + fr) * 136 + ks * 32 + fq * 8), bfr[ks], a);
            }
            f32x4 r0, r1;
#pragma unroll
            for (int jj = 0; jj < 4; ++jj) {
                const int jx = tj * 16 + 4 * fq + jj;
                const float d0 = fast_exp(fminf(gi0 - gc[jx], 0.f)), d1 = fast_exp(fminf(gi1 - gc[64 + jx], 0.f));
                r0[jj] = which ? (jx <= i ? a[jj] * d0 : 0.f) : (jx < i ? a[jj] * d0 * bi0 : 0.f);
                r1[jj] = which ? (jx <= i ? a[jj] * d1 : 0.f) : (jx < i ? a[jj] * d1 * bi1 : 0.f);
            }
            if (which == 0) { *(f32x4*)(Af + i * 68 + tj * 16 + 4 * fq) = r0; *(f32x4*)(Af + 64 * 68 + i * 68 + tj * 16 + 4 * fq) = r1; }
            else { *(u32x2*)(ATT0 + i * 64 + tj * 16 + 4 * fq) = pack4(r0); *(u32x2*)(ATT1 + i * 64 + tj * 16 + 4 * fq) = pack4(r1); }
        }
    }
    __syncthreads();
    {
        bf16_t* scr = qn;
        const int hh = (wave >> 1) & 1, blk = wave & 1, l32 = lane & 31;
        bf16_t* T11T = scr + hh * 3 * 1280; bf16_t* T22R = T11T + 1280; bf16_t* YT = T22R + 1280;
        bf16_t* Tbh = (bf16_t*)(Af + hh * 64 * 68);
        bf16x8 a21f[2];
        float t[32];
        if (wave < 4) {
            const float* Ah = Af + hh * 64 * 68;
            float ar[32];
#pragma unroll
            for (int i = 0; i < 32; ++i) ar[i] = Ah[(32 * blk + i) * 68 + 32 * blk + l32];
            if (blk == 0) {
#pragma unroll
                for (int ti = 0; ti < 2; ++ti) { const float* ap = Ah + (32 + 16 * ti + fr) * 68 + 8 * fq; a21f[ti] = cat8(pack4(*(const f32x4*)ap), pack4(*(const f32x4*)(ap + 4))); }
            }
            asm volatile("s_waitcnt lgkmcnt(0)" ::: "memory");
#pragma unroll
            for (int i = 0; i < 32; ++i) {
                float a0 = (i == l32) ? 1.f : 0.f, a1 = 0.f, a2 = 0.f, a3 = 0.f;
#pragma unroll
                for (int j = 0; j < i; ++j) {
                    const float sv = __int_as_float(__builtin_amdgcn_readlane(__float_as_int(ar[i]), j));
                    if ((j & 3) == 0) a0 -= sv * t[j]; else if ((j & 3) == 1) a1 -= sv * t[j]; else if ((j & 3) == 2) a2 -= sv * t[j]; else a3 -= sv * t[j];
                }
                t[i] = (a0 + a1) + (a2 + a3);
            }
            if (lane < 32) {
                if (blk == 0) {
#pragma unroll
                    for (int q = 0; q < 4; ++q) { u32x4 w; w.x = cvt_pk_bf16(t[8 * q], t[8 * q + 1]); w.y = cvt_pk_bf16(t[8 * q + 2], t[8 * q + 3]); w.z = cvt_pk_bf16(t[8 * q + 4], t[8 * q + 5]); w.w = cvt_pk_bf16(t[8 * q + 6], t[8 * q + 7]); *(u32x4*)(T11T + lane * 40 + q * 8) = w; }
                } else {
#pragma unroll
                    for (int i = 0; i < 32; ++i) T22R[i * 40 + lane] = f2bf(t[i]);
                }
            }
        }
        __syncthreads();
        if (wave < 4) {
            if (lane < 32) {
#pragma unroll
                for (int i = 0; i < 32; ++i) Tbh[(32 * blk + i) * 72 + 32 * blk + lane] = f2bf(t[i]);
                if (blk == 0) {
#pragma unroll
                    for (int i = 0; i < 32; ++i) Tbh[i * 72 + 32 + lane] = (bf16_t)0;
                }
            }
            if (blk == 0) {
#pragma unroll
                for (int tj = 0; tj < 2; ++tj) {
                    const bf16x8 bfr = *(const bf16x8*)(T11T + (16 * tj + fr) * 40 + 8 * fq);
#pragma unroll
                    for (int ti = 0; ti < 2; ++ti) {
                        f32x4 y = {0.f, 0.f, 0.f, 0.f}; y = mfma16(a21f[ti], bfr, y);
                        *(u32x2*)(YT + (16 * tj + fr) * 40 + 16 * ti + 4 * fq) = pack4(y);
                    }
                }
            }
        }
        __syncthreads();
        if (wave < 4 && blk == 1) {
#pragma unroll
            for (int ti = 0; ti < 2; ++ti) {
                const bf16x8 af = *(const bf16x8*)(T22R + (16 * ti + fr) * 40 + 8 * fq);
#pragma unroll
                for (int tj = 0; tj < 2; ++tj) {
                    const bf16x8 bfr = *(const bf16x8*)(YT + (16 * tj + fr) * 40 + 8 * fq);
                    f32x4 dd = {0.f, 0.f, 0.f, 0.f}; dd = mfma16(af, bfr, dd);
#pragma unroll
                    for (int jj = 0; jj < 4; ++jj) Tbh[(32 + 16 * ti + 4 * fq + jj) * 72 + 16 * tj + fr] = f2bf(-dd[jj]);
                }
            }
        }
    }
    __syncthreads();
    {
        const int td = wave;
#pragma unroll
        for (int h = 0; h < 2; ++h) {
            const bf16_t* kb = kbgT + h * 128 * 72; const bf16_t* vb = vbT + h * 128 * 72; const bf16_t* Tb = (const bf16_t*)(Af + h * 64 * 68);
            const int unit = (b * 16 + 2 * hq + h) * 32 + c;
            const bf16x8 a0 = *(const bf16x8*)(kb + (td * 16 + fr) * 72 + fq * 8), a1 = *(const bf16x8*)(kb + (td * 16 + fr) * 72 + 32 + fq * 8);
            const bf16x8 v0 = *(const bf16x8*)(vb + (td * 16 + fr) * 72 + fq * 8), v1 = *(const bf16x8*)(vb + (td * 16 + fr) * 72 + 32 + fq * 8);
            bf16_t* W = (bf16_t*)(p.ws + OFF_GW) + (size_t)unit * 8192; bf16_t* UT = (bf16_t*)(p.ws + OFF_GUT) + (size_t)unit * 8192;
#pragma unroll
            for (int ti = 0; ti < 4; ++ti) {
                const bf16x8 t0 = *(const bf16x8*)(Tb + (ti * 16 + fr) * 72 + fq * 8), t1 = *(const bf16x8*)(Tb + (ti * 16 + fr) * 72 + 32 + fq * 8);
                f32x4 w = {0.f, 0.f, 0.f, 0.f}; w = mfma16(a0, t0, w); w = mfma16(a1, t1, w);
                *(u32x2*)(W + (ti * 16 + fr) * 128 + td * 16 + 4 * fq) = pack4(w);
                f32x4 uu = {0.f, 0.f, 0.f, 0.f}; uu = mfma16(t0, v0, uu); uu = mfma16(t1, v1, uu);
                *(u32x2*)(UT + (td * 16 + fr) * 64 + ti * 16 + 4 * fq) = pack4(uu);
            }
        }
    }
    __syncthreads();
    asm volatile("" :: "v"(pf0), "v"(pf1));
}

__device__ __forceinline__ void gdn_g2_seq(const Params& p, unsigned char* shm, int seq) {
    const int tid = otid(), lane = tid & 63, wave = tid >> 6, fr = lane & 15, fq = lane >> 4;
    const int vh = seq & 15, b = seq >> 4, hq = vh >> 1;
    bf16_t* wS = (bf16_t*)shm;
    bf16_t* qg = wS + 64 * 136;
    bf16_t* kdT = qg + 64 * 136;
    bf16_t* att = kdT + 128 * 72;
    bf16_t* vnT = att + 64 * 72;
    bf16_t* St = vnT + 128 * 72;
    float* red = (float*)(St + 128 * 136);
    const bf16_t* P = (const bf16_t*)(p.ws + OFF_PROJ);
    bf16_t* Ob = (bf16_t*)(p.ws + OFF_O);
    const float* GCUM = (const float*)(p.ws + OFF_GCUM);
    f32x4 S[8];
#pragma unroll
    for (int tk = 0; tk < 8; ++tk) { S[tk] = (f32x4){0.f, 0.f, 0.f, 0.f}; *(u32x2*)(St + (wave * 16 + fr) * 136 + tk * 16 + 4 * fq) = (u32x2){0u, 0u}; }
    const f32x4 ng = *(const f32x4*)(p.gdn_norm + wave * 16 + 4 * fq);
    u32x4 wv[2], qv[2], kv[2], av; float giv[2], glast; u32x2 utn[4], zn[4];
#define G2_LOAD(cc) do { const int unit_ = seq * 32 + (cc), uq_ = (b * 8 + hq) * 32 + (cc); \
        const bf16_t* W_ = (const bf16_t*)(p.ws + OFF_GW) + (size_t)unit_ * 8192; const bf16_t* QN_ = (const bf16_t*)(p.ws + OFF_QN) + (size_t)uq_ * 8192; const bf16_t* KN_ = (const bf16_t*)(p.ws + OFF_KN) + (size_t)uq_ * 8192; \
        const bf16_t* UT_ = (const bf16_t*)(p.ws + OFF_GUT) + (size_t)unit_ * 8192; \
        _Pragma("unroll") for (int it = 0; it < 2; ++it) { const int e = tid + 512 * it, i = e >> 4, ch = e & 15; wv[it] = *(const u32x4*)(W_ + i * 128 + ch * 8); qv[it] = *(const u32x4*)(QN_ + i * 128 + ch * 8); kv[it] = *(const u32x4*)(KN_ + i * 128 + ch * 8); giv[it] = GCUM[(size_t)unit_ * 64 + i]; } \
        { const int i = tid >> 3, ch = tid & 7; av = *(const u32x4*)((const bf16_t*)(p.ws + OFF_ATT) + (size_t)unit_ * 4096 + i * 64 + ch * 8); } \
        glast = GCUM[(size_t)unit_ * 64 + 63]; \
        _Pragma("unroll") for (int ti = 0; ti < 4; ++ti) { utn[ti] = *(const u32x2*)(UT_ + (wave * 16 + fr) * 64 + ti * 16 + 4 * fq); \
            zn[ti] = *(const u32x2*)(P + ((size_t)b * 2048 + (cc) * 64 + ti * 16 + fr) * 6400 + 4096 + vh * 128 + wave * 16 + 4 * fq); } } while (0)
    G2_LOAD(0);
#pragma unroll 1
    for (int c = 0; c < 32; ++c) {
        const int unit = seq * 32 + c, uq = (b * 8 + hq) * 32 + c;
        __syncthreads();
        const float glc = glast;
        u32x2 utr[4], zr[4];
#pragma unroll
        for (int ti = 0; ti < 4; ++ti) { utr[ti] = utn[ti]; zr[ti] = zn[ti]; }
        {
#pragma unroll
            for (int it = 0; it < 2; ++it) {
                const int e = tid + 512 * it, i = e >> 4, ch = e & 15;
                *(u32x4*)(wS + i * 136 + ch * 8) = wv[it];
                const float gi = giv[it]; const float eq = fast_exp(gi), ek = fast_exp(glc - gi);
                u32x4 qo;
#pragma unroll
                for (int q = 0; q < 4; ++q) qo[q] = cvt_pk_bf16(bflo(qv[it][q]) * eq, bfhi(qv[it][q]) * eq);
#pragma unroll
                for (int q = 0; q < 4; ++q) {
                    const int qq = (q + ch) & 3; const unsigned kw = qq == 0 ? kv[it][0] : (qq == 1 ? kv[it][1] : (qq == 2 ? kv[it][2] : kv[it][3]));
                    kdT[(ch * 8 + 2 * qq) * 72 + i] = f2bf(bflo(kw) * ek); kdT[(ch * 8 + 2 * qq + 1) * 72 + i] = f2bf(bfhi(kw) * ek);
                }
                *(u32x4*)(qg + i * 136 + ch * 8) = qo;
            }
            { const int i = tid >> 3, ch = tid & 7; *(u32x4*)(att + i * 72 + ch * 8) = av; }
        }
        if (c + 1 < 32) G2_LOAD(c + 1);
        __syncthreads();
        bf16x8 sf[4];
#pragma unroll
        for (int ks = 0; ks < 4; ++ks) sf[ks] = *(const bf16x8*)(St + (wave * 16 + fr) * 136 + ks * 32 + fq * 8);
        {
#pragma unroll
            for (int ti = 0; ti < 4; ++ti) {
                f32x4 a = {0.f, 0.f, 0.f, 0.f};
#pragma unroll
                for (int ks = 0; ks < 4; ++ks) a = mfma16(*(const bf16x8*)(wS + (ti * 16 + fr) * 136 + ks * 32 + fq * 8), sf[ks], a);
                const f32x4 uu = unpack4(utr[ti]);
                *(u32x2*)(vnT + (wave * 16 + fr) * 72 + ti * 16 + 4 * fq) = pack4(uu - a);
            }
        }
        asm volatile("s_waitcnt lgkmcnt(0)" ::: "memory");
        bf16x8 vf[2];
#pragma unroll
        for (int ks = 0; ks < 2; ++ks) vf[ks] = *(const bf16x8*)(vnT + (wave * 16 + fr) * 72 + ks * 32 + fq * 8);
        f32x4 o[4];
#pragma unroll
        for (int ti = 0; ti < 4; ++ti) {
            f32x4 a = {0.f, 0.f, 0.f, 0.f};
#pragma unroll
            for (int ks = 0; ks < 4; ++ks) a = mfma16(sf[ks], *(const bf16x8*)(qg + (ti * 16 + fr) * 136 + ks * 32 + fq * 8), a);
#pragma unroll
            for (int ks = 0; ks < 2; ++ks) a = mfma16(vf[ks], *(const bf16x8*)(att + (ti * 16 + fr) * 72 + ks * 32 + fq * 8), a);
            o[ti] = a;
            float s2 = (a[0] * a[0] + a[1] * a[1]) + (a[2] * a[2] + a[3] * a[3]);
            s2 += __shfl_xor(s2, 16); s2 += __shfl_xor(s2, 32);
            if (fq == 0) red[wave * 64 + ti * 16 + fr] = s2;
        }
        __syncthreads();
#pragma unroll
        for (int ti = 0; ti < 4; ++ti) {
            const int i = ti * 16 + fr; float tot = 0.f;
#pragma unroll
            for (int w = 0; w < 8; ++w) tot += red[w * 64 + i];
            const float rn = rsqrtf(tot * (1.0f / 128.0f) + EPS);
            const size_t row = (size_t)b * 2048 + c * 64 + i;
            const f32x4 z = unpack4(zr[ti]);
            f32x4 r;
#pragma unroll
            for (int jj = 0; jj < 4; ++jj) r[jj] = o[ti][jj] * rn * ng[jj] * siluf_(z[jj]);
            *(u32x2*)(Ob + row * 2048 + vh * 128 + wave * 16 + 4 * fq) = pack4(r);
        }
        {
            const float eg = fast_exp(glc);
#pragma unroll
            for (int tk = 0; tk < 8; ++tk) {
                f32x4 a = S[tk] * eg;
#pragma unroll
                for (int ks = 0; ks < 2; ++ks) a = mfma16(*(const bf16x8*)(kdT + (tk * 16 + fr) * 72 + ks * 32 + fq * 8), vf[ks], a);
                S[tk] = a;
                *(u32x2*)(St + (wave * 16 + fr) * 136 + tk * 16 + 4 * fq) = pack4(a);
            }
        }
    }
    float* pg = p.out + OUT_PG + (size_t)(b * 16 + vh) * 16384;
#pragma unroll
    for (int tk = 0; tk < 8; ++tk)
#pragma unroll
        for (int jj = 0; jj < 4; ++jj) pg[(tk * 16 + 4 * fq + jj) * 128 + wave * 16 + fr] = S[tk][jj];
    __syncthreads();
}

__device__ __forceinline__ void gs_load_state(const Params& p, int item, float (&s)[32]) {
    const int tid = otid(), dv = tid & 127, grp = tid >> 7;
    const float* sp = p.state_gdn + (size_t)item * 16384;
#pragma unroll
    for (int e = 0; e < 32; ++e) s[e] = sp[(grp * 32 + e) * 128 + dv];
}
__device__ __forceinline__ void gdn_sample_item(const Params& p, unsigned char* shm, int item, float (&s)[32], int next_item) {
    const int tid = otid(), lane = tid & 63, wave = tid >> 6;
    const int vh = item & 15, b = item >> 4, hq = vh >> 1;
    const bf16_t* P = (const bf16_t*)(p.ws + OFF_PROJ);
    const float* BA = (const float*)(p.ws + OFF_BA);
    bf16_t* Ob = (bf16_t*)(p.ws + OFF_O);
    float* qs = (float*)shm; float* ks = qs + 512; float* vs = ks + 512; float* red = vs + 512; float* sc = red + 4096; float* part = sc + 16;
    const int t = tid >> 7, col = tid & 127;
    const int dv = tid & 127, grp = tid >> 7;
    bf16_t zg[4];
#pragma unroll
    for (int tt = 0; tt < 4; ++tt) zg[tt] = P[(size_t)(MP + b * 4 + tt) * 6400 + 4096 + vh * 128 + dv];
    const float ngd = p.gdn_norm[dv];
    __syncthreads();
#pragma unroll
    for (int op = 0; op < 3; ++op) {
        const int cc = op == 0 ? hq * 128 + col : (op == 1 ? 1024 + hq * 128 + col : 2048 + vh * 128 + col);
        float acc = 0.f, xlast = 0.f;
#pragma unroll
        for (int jj = 0; jj < 4; ++jj) {
            const int xi = t + jj;
            const float x = xi < 3 ? p.state_conv[(size_t)(b * 3 + xi) * 4096 + cc] : bf2f(P[(size_t)(MP + b * 4 + xi - 3) * 6400 + cc]);
            acc += x * p.gdn_conv_w[jj * 4096 + cc]; xlast = x;
        }
        if (t >= 1 && (op == 2 || (vh & 1) == 0)) p.out[OUT_SC + (size_t)(b * 3 + t - 1) * 4096 + cc] = xlast;
        acc = siluf_(acc);
        (op == 0 ? qs : (op == 1 ? ks : vs))[tid] = acc;
    }
    if (tid < 4) {
        const size_t r = MP + b * 4 + tid;
        const float a = BA[r * 32 + 16 + vh] + p.gdn_dt_bias[vh];
        const float sp = a > 20.f ? a : log1pf(expf(a));
        sc[tid] = -expf(p.gdn_a_log[vh]) * sp; sc[4 + tid] = 1.0f / (1.0f + expf(-BA[r * 32 + vh]));
    }
    __syncthreads();
    {
        const float q = qs[tid], k = ks[tid];
        const float sq = wave_sum(q * q), sk = wave_sum(k * k);
        if (lane == 0) { part[wave] = sq; part[8 + wave] = sk; }
        __syncthreads();
        const float tq = part[2 * t] + part[2 * t + 1], tk = part[8 + 2 * t] + part[8 + 2 * t + 1];
        qs[tid] = q * rsqrtf(tq + 1e-6f) * 0.08838834764831845f; ks[tid] = k * rsqrtf(tk + 1e-6f);
    }
    __syncthreads();
    float sn[32];
    if (next_item < 2048) gs_load_state(p, next_item, sn);
#pragma unroll
    for (int tt = 0; tt < 4; ++tt) {
        const float eg = fast_exp(sc[tt]), be = sc[4 + tt];
        float r = 0.f;
#pragma unroll
        for (int e = 0; e < 32; ++e) { s[e] *= eg; r += s[e] * ks[tt * 128 + grp * 32 + e]; }
        float* rr_ = red + tt * 1024; float* ro_ = rr_ + 512; float* pt_ = part + 16 + tt * 8;
        rr_[grp * 128 + dv] = r;
        __syncthreads();
        const float rt = (rr_[dv] + rr_[128 + dv]) + (rr_[256 + dv] + rr_[384 + dv]);
        const float delta = be * (vs[tt * 128 + dv] - rt);
        float o = 0.f;
#pragma unroll
        for (int e = 0; e < 32; ++e) { s[e] += ks[tt * 128 + grp * 32 + e] * delta; o += s[e] * qs[tt * 128 + grp * 32 + e]; }
        ro_[grp * 128 + dv] = o;
        __syncthreads();
        const float ot = (ro_[dv] + ro_[128 + dv]) + (ro_[256 + dv] + ro_[384 + dv]);
        const float so = wave_sum(ot * ot);
        if (lane == 0) pt_[wave] = so;
        __syncthreads();
        const float rn = rsqrtf((pt_[2 * grp] + pt_[2 * grp + 1]) * (1.0f / 128.0f) + EPS);
        if (grp == 0) {
            const size_t row = MP + b * 4 + tt;
            const float z = bf2f(zg[tt]);
            Ob[row * 2048 + vh * 128 + dv] = f2bf(ot * rn * ngd * siluf_(z));
        }
    }
    float* sg = p.out + OUT_SG + (size_t)(b * 16 + vh) * 16384;
#pragma unroll
    for (int e = 0; e < 32; ++e) sg[(grp * 32 + e) * 128 + dv] = s[e];
    if (next_item < 2048) {
#pragma unroll
        for (int e = 0; e < 32; ++e) s[e] = sn[e];
    }
}

__device__ __forceinline__ void hgrn_seq(const Params& p, unsigned char* shm, int seq) {
    const int tid = otid(), lane = tid & 63, wave = tid >> 6, fr = lane & 15, fq = lane >> 4;
    const int h = seq & 7, b = seq >> 3;
    bf16_t* qS = (bf16_t*)shm;
    bf16_t* qe = qS + 32 * 136;
    bf16_t* ke = qe + 32 * 136;
    bf16_t* kST = ke + 32 * 136;
    bf16_t* vT = kST + 128 * 40;
    bf16_t* att = vT + 128 * 40;
    bf16_t* St = att + 32 * 40;
    float* offs = (float*)(St + 128 * 136);
    float* elast = offs + 1024;
    float* red = elast + 128;
    const bf16_t* P = (const bf16_t*)(p.ws + OFF_PROJ);
    const float* FZ = (const float*)(p.ws + OFF_FZ);
    bf16_t* Ob = (bf16_t*)(p.ws + OFF_O);
    const int d = tid & 127, rg = tid >> 7;
    const float lb = ((const float*)(p.ws + OFF_LB))[h * 128 + d];
    f32x4 S[8];
#pragma unroll
    for (int tk = 0; tk < 8; ++tk) { S[tk] = (f32x4){0.f, 0.f, 0.f, 0.f}; *(u32x2*)(St + (wave * 16 + fr) * 136 + tk * 16 + 4 * fq) = (u32x2){0u, 0u}; }
    const f32x4 ng = *(const f32x4*)(p.hgrn_norm + wave * 16 + 4 * fq);
    float fzn[8]; bf16_t qn_[8], vn_[8]; u32x2 zn_[2];
    {
        const size_t r00 = (size_t)b * 2048;
#pragma unroll
        for (int e = 0; e < 8; ++e) { const size_t r = r00 + rg * 8 + e; fzn[e] = FZ[r * 1024 + h * 128 + d]; qn_[e] = P[r * 4096 + h * 128 + d]; vn_[e] = P[r * 4096 + 2048 + h * 128 + d]; }
#pragma unroll
        for (int ti = 0; ti < 2; ++ti) zn_[ti] = *(const u32x2*)(P + (r00 + ti * 16 + fr) * 4096 + 3072 + h * 128 + wave * 16 + 4 * fq);
    }
#pragma unroll 1
    for (int c = 0; c < 64; ++c) {
        const size_t r0 = (size_t)b * 2048 + c * 32;
        float lf[8], kk[8], qq[8], vv[8];
#pragma unroll
        for (int e = 0; e < 8; ++e) {
            const float fz = fminf(fmaxf(fzn[e], -60.f), 60.f);
            const float e1 = fast_exp(-fz), sg = __builtin_amdgcn_rcpf(1.0f + e1), sn = e1 * sg;
            lf[e] = fast_log(lb + (1.0f - lb) * sg); kk[e] = (1.0f - lb) * sn;
            qq[e] = siluf_(bf2f(qn_[e])); vv[e] = bf2f(vn_[e]);
        }
        u32x2 zcur[2] = {zn_[0], zn_[1]};
        if (c + 1 < 64) {
#pragma unroll
            for (int e = 0; e < 8; ++e) { const size_t r = r0 + 32 + rg * 8 + e; fzn[e] = FZ[r * 1024 + h * 128 + d]; qn_[e] = P[r * 4096 + h * 128 + d]; vn_[e] = P[r * 4096 + 2048 + h * 128 + d]; }
#pragma unroll
            for (int ti = 0; ti < 2; ++ti) zn_[ti] = *(const u32x2*)(P + (r0 + 32 + ti * 16 + fr) * 4096 + 3072 + h * 128 + wave * 16 + 4 * fq);
        }
        float cs[8]; float run = 0.f;
#pragma unroll
        for (int e = 0; e < 8; ++e) { run += lf[e]; cs[e] = run; }
        float* ofs = offs + (c & 1) * 512;
        ofs[rg * 128 + d] = run;
        __syncthreads();
        const float o0 = ofs[d], o1 = ofs[128 + d], o2 = ofs[256 + d], o3 = ofs[384 + d];
        const float base = rg == 0 ? 0.f : (rg == 1 ? o0 : (rg == 2 ? o0 + o1 : o0 + o1 + o2));
        const float tot = (o0 + o1) + (o2 + o3), bref = o0 + o1;
        const float Etot = fast_exp(tot), Eref = fast_exp(bref), Erefi = fast_exp(fminf(-bref, 85.f));
        float Ebc[8], Einv[8];
#pragma unroll
        for (int e = 0; e < 8; ++e) { const float bc = base + cs[e]; Ebc[e] = fast_exp(bc); Einv[e] = fast_exp(fminf(-bc, 85.f)); }
        u32x4 kw, vw;
#pragma unroll
        for (int e = 0; e < 8; e += 2) {
            kw[e >> 1] = cvt_pk_bf16(kk[e] * Einv[e] * Etot, kk[e + 1] * Einv[e + 1] * Etot);
            vw[e >> 1] = cvt_pk_bf16(vv[e], vv[e + 1]);
        }
        *(u32x4*)(kST + d * 40 + rg * 8) = kw; *(u32x4*)(vT + d * 40 + rg * 8) = vw;
#pragma unroll
        for (int e = 0; e < 8; ++e) {
            const float bc = base + cs[e]; const int i = rg * 8 + e;
            const float qE = qq[e] * Ebc[e];
            qS[i * 136 + d] = f2bf(qE); qe[i * 136 + d] = f2bf(qE * Erefi); ke[i * 136 + d] = f2bf(kk[e] * Einv[e] * Eref);
        }
        if (rg == 0) elast[d] = Etot;
        __syncthreads();
        bf16x8 sf[4];
#pragma unroll
        for (int ks = 0; ks < 4; ++ks) sf[ks] = *(const bf16x8*)(St + (wave * 16 + fr) * 136 + ks * 32 + fq * 8);
        const bf16x8 vf = *(const bf16x8*)(vT + (wave * 16 + fr) * 40 + fq * 8);
        const bf16x8 vperm = cat8(*(const u32x2*)(vT + (wave * 16 + fr) * 40 + 4 * fq), *(const u32x2*)(vT + (wave * 16 + fr) * 40 + 16 + 4 * fq));
        f32x4 o[2];
#pragma unroll
        for (int ti = 0; ti < 2; ++ti) {
            f32x4 a = {0.f, 0.f, 0.f, 0.f};
#pragma unroll
            for (int ks = 0; ks < 4; ++ks) a = mfma16(sf[ks], *(const bf16x8*)(qS + (ti * 16 + fr) * 136 + ks * 32 + fq * 8), a);
            {
                f32x4 at0 = {0.f, 0.f, 0.f, 0.f}, at1 = {0.f, 0.f, 0.f, 0.f};
#pragma unroll
                for (int ks = 0; ks < 4; ++ks) {
                    const bf16x8 qf = *(const bf16x8*)(qe + (ti * 16 + fr) * 136 + ks * 32 + fq * 8);
                    at0 = mfma16(*(const bf16x8*)(ke + fr * 136 + ks * 32 + fq * 8), qf, at0);
                    at1 = mfma16(*(const bf16x8*)(ke + (16 + fr) * 136 + ks * 32 + fq * 8), qf, at1);
                }
                const int irow = ti * 16 + fr;
#pragma unroll
                for (int jj = 0; jj < 4; ++jj) { if (4 * fq + jj > irow) at0[jj] = 0.f; if (16 + 4 * fq + jj > irow) at1[jj] = 0.f; }
                a = mfma16(vperm, cat8(pack4(at0), pack4(at1)), a);
            }
            o[ti] = a;
            float s2 = (a[0] * a[0] + a[1] * a[1]) + (a[2] * a[2] + a[3] * a[3]);
            s2 += __shfl_xor(s2, 16); s2 += __shfl_xor(s2, 32);
            if (fq == 0) red[wave * 32 + ti * 16 + fr] = s2;
        }
        __syncthreads();
#pragma unroll
        for (int ti = 0; ti < 2; ++ti) {
            const int i = ti * 16 + fr; float tt = 0.f;
#pragma unroll
            for (int w = 0; w < 8; ++w) tt += red[w * 32 + i];
            const float rn = rsqrtf(tt * (1.0f / 128.0f) + EPS);
            const size_t row = r0 + i;
            const f32x4 z = unpack4(zcur[ti]);
            f32x4 r;
#pragma unroll
            for (int jj = 0; jj < 4; ++jj) r[jj] = o[ti][jj] * rn * ng[jj] * siluf_(z[jj]);
            *(u32x2*)(Ob + row * 1024 + h * 128 + wave * 16 + 4 * fq) = pack4(r);
        }
#pragma unroll
        for (int tk = 0; tk < 8; ++tk) {
            const f32x4 el = *(const f32x4*)(elast + tk * 16 + 4 * fq);
            f32x4 a = S[tk] * el;
            a = mfma16(*(const bf16x8*)(kST + (tk * 16 + fr) * 40 + fq * 8), vf, a);
            S[tk] = a;
            *(u32x2*)(St + (wave * 16 + fr) * 136 + tk * 16 + 4 * fq) = pack4(a);
        }
    }
    float* ph = p.out + OUT_PH + (size_t)(b * 8 + h) * 16384;
#pragma unroll
    for (int tk = 0; tk < 8; ++tk)
#pragma unroll
        for (int jj = 0; jj < 4; ++jj) ph[(tk * 16 + 4 * fq + jj) * 128 + wave * 16 + fr] = S[tk][jj];
    __syncthreads();
}

__device__ __forceinline__ void hgrn_sample_item(const Params& p, unsigned char* shm, int item) {
    const int tid = otid(), lane = tid & 63, wave = tid >> 6;
    const int h = item & 7, b = item >> 3;
    const bf16_t* P = (const bf16_t*)(p.ws + OFF_PROJ);
    const float* FZ = (const float*)(p.ws + OFF_FZ);
    bf16_t* Ob = (bf16_t*)(p.ws + OFF_O);
    float* fs = (float*)shm; float* ks = fs + 512; float* qs = ks + 512; float* vs = qs + 512; float* red = vs + 512; float* part = red + 512;
    const int t = tid >> 7, d = tid & 127;
    __syncthreads();
    {
        const size_t r = MP + b * 4 + t;
        const float lb = ((const float*)(p.ws + OFF_LB))[h * 128 + d];
        const float fz = FZ[r * 1024 + h * 128 + d];
        const float sg = __builtin_amdgcn_rcpf(1.0f + fast_exp(-fz)), sn = __builtin_amdgcn_rcpf(1.0f + fast_exp(fz));
        fs[tid] = lb + (1.0f - lb) * sg; ks[tid] = (1.0f - lb) * sn;
        qs[tid] = siluf_(bf2f(P[r * 4096 + h * 128 + d])); vs[tid] = bf2f(P[r * 4096 + 2048 + h * 128 + d]);
    }
    __syncthreads();
    const int dv = tid & 127, grp = tid >> 7;
    float s[32];
    const float* sp = p.state_hgrn + (size_t)(b * 8 + h) * 16384;
#pragma unroll
    for (int e = 0; e < 32; ++e) s[e] = sp[(grp * 32 + e) * 128 + dv];
#pragma unroll 1
    for (int tt = 0; tt < 4; ++tt) {
        const float v = vs[tt * 128 + dv]; float o = 0.f;
#pragma unroll
        for (int e = 0; e < 32; ++e) { const int dk = tt * 128 + grp * 32 + e; s[e] = fs[dk] * s[e] + ks[dk] * v; o += s[e] * qs[dk]; }
        red[grp * 128 + dv] = o;
        __syncthreads();
        const float ot = (red[dv] + red[128 + dv]) + (red[256 + dv] + red[384 + dv]);
        const float so = wave_sum(ot * ot);
        if (lane == 0) part[wave] = so;
        __syncthreads();
        const float rn = rsqrtf((part[2 * grp] + part[2 * grp + 1]) * (1.0f / 128.0f) + EPS);
        if (grp == 0) {
            const size_t row = MP + b * 4 + tt;
            const float z = bf2f(P[row * 4096 + 3072 + h * 128 + dv]);
            Ob[row * 1024 + h * 128 + dv] = f2bf(ot * rn * p.hgrn_norm[dv] * siluf_(z));
        }
        __syncthreads();
    }
    float* sh = p.out + OUT_SH + (size_t)(b * 8 + h) * 16384;
#pragma unroll
    for (int e = 0; e < 32; ++e) sh[(grp * 32 + e) * 128 + dv] = s[e];
}

__device__ __forceinline__ void touch_resid_tile(const Params& p) {
    pg8::StaticOrder so; so.init(M_TOK, 1024, gridDim.x, obid());
    Unit u;
    if (!so.next(0, u)) return;
    const int tid = otid();
    const float* base = p.out + (size_t)u.pm * 256 * 1024 + u.pn * 256;
#pragma unroll
    for (int k = 0; k < 4; ++k) { const int line = tid + 512 * k; (void)*(const volatile float*)(base + (size_t)(line >> 3) * 1024 + (line & 7) * 32); }
}
__device__ __forceinline__ void fill_rs_table(const pg8::StaticOrder& so, const float* ss, PG8_LAS float* rsb) {
    const int t = otid();
    f32x4 pa[7][4]; int rowi[7];
#pragma unroll
    for (int i = 0; i < 7; ++i) {
        Unit uu; rowi[i] = so.next(i, uu) ? uu.pm * 256 + t : -1;
        if (rowi[i] >= 0 && t < 256) { const f32x4* sp = (const f32x4*)(ss + (size_t)rowi[i] * 16); pa[i][0] = sp[0]; pa[i][1] = sp[1]; pa[i][2] = sp[2]; pa[i][3] = sp[3]; }
    }
#pragma unroll
    for (int i = 0; i < 7; ++i)
        if (rowi[i] >= 0 && t < 256) { const f32x4 q = (pa[i][0] + pa[i][1]) + (pa[i][2] + pa[i][3]); rsb[i * 256 + t] = rsqrtf(((q[0] + q[1]) + (q[2] + q[3])) * (1.0f / 1024.0f) + EPS); }
    __syncthreads();
}
__device__ __forceinline__ void run_phase(const Params& p, unsigned char* shm, int code) {

#ifndef NO_PRO
    if (code == 0xF0) { ph_prologue(p, shm); return; }
#endif

    if (code == 0xF1) { ph_final(p); return; }
    const bool dry = (code & 0x40) != 0; code &= 0x3f;
    const int layer = code >> 4, sub = code & 15, kind = layer % 3, jm = layer / 3;
    float* SS = (float*)(p.ws + OFF_SS);
    bf16_t* XG = (bf16_t*)(p.ws + OFF_XG); bf16_t* HID = (bf16_t*)(p.ws + OFF_HID); bf16_t* PROJ = (bf16_t*)(p.ws + OFF_PROJ); bf16_t* Ob = (bf16_t*)(p.ws + OFF_O);
    PG8_LAS unsigned char* lds = (PG8_LAS unsigned char*)shm;
    pg8::StaticOrder so;
    if (sub == 0 || sub == 6) {
        const int s = sub == 0 ? 0 : 1;
        pg8::Gemm g; g.A = XG; g.Bt = (const bf16_t*)(p.ws + WT_FFN_IN) + (size_t)(layer * 2 + s) * 5632 * 1024; g.M = M_TOK; g.N = 5632; g.K = 1024; g.ld = 1024;
        EpiSwiglu e; e.rsb = (PG8_LAS float*)(lds + RS_LDS_OFF); e.H = HID; e.ss = SS + (size_t)((3 * layer + (s ? 2 : 0)) & 1) * M_TOK * 16;
        so.init(g.M, g.N, gridDim.x, obid());
        fill_rs_table(so, e.ss, e.rsb);
#ifndef NO_GE1
 pg8::gemm_phase<EpiSwiglu, pg8::StaticOrder, false>(lds, g, so, e, nullptr);
#endif

    } else if (sub == 1 || sub == 5 || sub == 7) {
        pg8::Gemm g; EpiResid e; e.X = p.out; e.XG = XG; g.M = M_TOK; g.N = 1024;
        if (sub == 1) { g.A = HID; g.K = DFF; g.Bt = (const bf16_t*)(p.ws + WT_FFN_OUT) + (size_t)(layer * 2) * 1024 * DFF; e.scale = 0.5f; e.iscale = 2.0f; e.g = p.norm_mix + layer * 1024; e.ssn = SS + (size_t)((3 * layer + 1) & 1) * M_TOK * 16; }
        else if (sub == 7) { g.A = HID; g.K = DFF; g.Bt = (const bf16_t*)(p.ws + WT_FFN_OUT) + (size_t)(layer * 2 + 1) * 1024 * DFF; e.scale = 0.5f; e.iscale = 2.0f; e.g = layer < 3 ? p.norm_ffn + (size_t)((layer + 1) * 2) * 1024 : p.final_norm; e.ssn = SS + (size_t)((3 * layer + 3) & 1) * M_TOK * 16; }
        else { g.A = Ob; e.scale = 1.0f; e.iscale = 1.0f; e.g = p.norm_ffn + (size_t)(layer * 2 + 1) * 1024; e.ssn = SS + (size_t)((3 * layer + 2) & 1) * M_TOK * 16;
            if (kind == 0) { g.K = 1024; g.Bt = (const bf16_t*)(p.ws + WT_SWA_OUT) + (size_t)jm * 1024 * 1024; }
            else if (kind == 1) { g.K = 2048; g.Bt = (const bf16_t*)(p.ws + WT_GDN_OUT); }
            else { g.K = 1024; g.Bt = (const bf16_t*)(p.ws + WT_HG_OUT); } }
        e.pm0 = 0; g.ld = g.K; g.M = USE_SPLIT ? MP : M_TOK;
        so.init(g.M, g.N, gridDim.x, obid());
#ifndef NO_GE2
        {
            const int bid = obid(), KT = g.K >> 6, q = KT >> 2, sp = bid >> 3, u8 = bid & 7;
            const int big = (q & 1) ? q + 1 : q, small = (q & 1) ? q - 1 : q;
            const int k0 = (sp < 2 ? sp * big : 2 * big + (sp - 2) * small) * 64, len = (sp < 2 ? big : small) * 64;
            pg8::Gemm g2 = g; g2.A = g.A + k0; g2.Bt = g.Bt + k0; g2.K = len; g2.M = M_TOK;
            OneUnit ou; ou.have = bid < 32; ou.pm = 64 + (u8 >> 2); ou.pn = u8 & 3;
            EpiSplit es; es.R = e; es.part = (float*)(p.ws + OFF_PART); es.cnt = (unsigned*)(p.ws + OFF_CNT) + (layer * 3 + (sub == 1 ? 0 : (sub == 5 ? 1 : 2))) * 8; es.unit8 = u8; es.split = sp; es.ns = 4;
#if USE_SPLIT
            pg8::gemm_phase<EpiSplit, OneUnit, false>(lds, g2, ou, es, nullptr);
#endif
        }
        pg8::gemm_phase<EpiResid, pg8::StaticOrder, false>(lds, g, so, e, nullptr);
        if (obid() >= 8) convert_weights(p, shm, 1 + layer * 3 + (sub == 1 ? 0 : (sub == 5 ? 1 : 2)), obid() - 8, gridDim.x - 8);
#endif

    } else if (sub == 2) {
        pg8::Gemm g; g.A = XG; g.M = M_TOK; g.K = 1024; g.ld = 1024; EpiProj e; e.rsb = (PG8_LAS float*)(lds + RS_LDS_OFF); e.P = PROJ; e.ss = SS + (size_t)((3 * layer + 1) & 1) * M_TOK * 16; e.mode = kind; e.rope = (const float*)(p.ws + OFF_ROPE);
        if (kind == 0) { g.N = 1536; g.Bt = (const bf16_t*)(p.ws + WT_SWA_IN) + (size_t)jm * 1536 * 1024; e.side = nullptr; }
        else if (kind == 1) { g.N = 6400; g.Bt = (const bf16_t*)(p.ws + WT_GDN_IN); e.side = (float*)(p.ws + OFF_BA); }
        else { g.N = 4096; g.Bt = (const bf16_t*)(p.ws + WT_HG_IN); e.side = (float*)(p.ws + OFF_FZ); }
        e.ld = g.N;
        so.init(g.M, g.N, gridDim.x, obid());
        fill_rs_table(so, e.ss, e.rsb);
#ifndef NO_GE3
 pg8::gemm_phase<EpiProj, pg8::StaticOrder, false>(lds, g, so, e, nullptr);
#endif

    } else if (sub == 3) {
        if (kind == 0) {
            for (int it = obid(); it < 1024; it += gridDim.x) {
#ifndef NO_SWAP
 if (it < 512) swa_prompt_item(p, shm, jm, it);
#endif
#ifndef NO_SWAS
 if (it >= 512) swa_sample_item(p, shm, jm, it - 512);
#endif
 }
            } else if (kind == 1) {

#ifndef NO_G1
#if G1_PAIR
 for (int u = obid(); u < 2048; u += gridDim.x) gdn_g1_pair(p, shm, u);
#if GS_EARLY
 for (int it = obid(); it < GS_EARLY; it += gridDim.x) { float s0[32]; gs_load_state(p, it, s0); gdn_sample_item(p, shm, it, s0, 4096); }
#endif
#else
 for (int u = obid(); u < 4096; u += gridDim.x) gdn_g1_unit(p, shm, u);
#endif
#endif

        } else {

#ifndef NO_HG
 if (obid() < 64) hgrn_seq(p, shm, obid());
#endif


#ifndef NO_HGS
 if (obid() >= 64) for (int it = obid() - 64; it < 1024; it += gridDim.x - 64) hgrn_sample_item(p, shm, it);
#endif

        }
    } else if (sub == 4) {

#ifndef NO_G2
 if (obid() < 128) gdn_g2_seq(p, shm, obid());
#endif


#ifndef NO_GS
 if (obid() >= 128) { float st_[32]; const int st0 = GS_EARLY + obid() - 128, sd = gridDim.x - 128; if (st0 < 2048) gs_load_state(p, st0, st_); for (int it = st0; it < 2048; it += sd) gdn_sample_item(p, shm, it, st_, it + sd); }
#endif

    }
}

__global__ __launch_bounds__(512, 2) void mega(Params p, int ph_lo, int ph_hi) {
    extern __shared__ __attribute__((aligned(16))) unsigned char shm[];
    cg::grid_group grid = cg::this_grid();
    volatile LAS unsigned* st = (volatile LAS unsigned*)(shm + LDS_PHASE);
    if (threadIdx.x < 4) st[threadIdx.x] = 0u;
    __syncthreads();
    XcdBarrier xb = xcd_barrier_post((unsigned*)(p.ws + OFF_BAR), st);
    for (int ph = ph_lo; ph < ph_hi; ++ph) {
        run_phase(p, shm, p.prog[ph]);
        if (ph + 1 < ph_hi) { if (p.nprog < 0) grid.sync(); else xcd_barrier(xb);
#if REP_SYNC
            xcd_barrier(xb); xcd_barrier(xb);
#endif
        }
    }
}

extern "C" void kernel_launch(void* const* d_in, const int* in_sizes, int n_in, void* d_out, int out_size, void* d_ws, size_t ws_size, hipStream_t stream) {
    static int grid_blocks = 0;
    if (grid_blocks == 0) {
        if (n_in != 25 || (size_t)out_size != OUT_END || ws_size < WS_END) { fprintf(stderr, "kernel_launch: unexpected shapes n_in %d out %d ws %zu (need %zu)\n", n_in, out_size, ws_size, (size_t)WS_END); grid_blocks = -1; return; }
        int dev = 0, cus = 0, per_cu = 0;
        hipGetDevice(&dev); hipDeviceGetAttribute(&cus, hipDeviceAttributeMultiprocessorCount, dev);
        if (hipFuncSetAttribute((const void*)mega, hipFuncAttributeMaxDynamicSharedMemorySize, LDS_BYTES) != hipSuccess) { fprintf(stderr, "kernel_launch: hipFuncSetAttribute failed\n"); grid_blocks = -1; return; }
        if (hipOccupancyMaxActiveBlocksPerMultiprocessor(&per_cu, (const void*)mega, 512, LDS_BYTES) != hipSuccess || per_cu < 1) { fprintf(stderr, "kernel_launch: occupancy query gave %d\n", per_cu); per_cu = 1; }
        (void)hipGetLastError();
        grid_blocks = cus * 1;
    }
    if (grid_blocks < 0) return;
    Params p{};
    const float** f = (const float**)&p.x_prompt;
    for (int i = 0; i < 25; ++i) f[i] = (const float*)d_in[i];
    p.out = (float*)d_out; p.ws = (unsigned char*)d_ws;
    for (int i = 0; i < 8; ++i) p.inv_freq[i] = (float)pow(500000.0, -(double)i / 8.0);
    {
        int n = 0, t0 = 0; unsigned char* ws = (unsigned char*)d_ws;
        auto add = [&](const float* src, size_t dst_off, int K, int N, int Nrows, int mode) { WD& w = p.wd[n++]; w.src = src; w.dst = (bf16_t*)(ws + dst_off); w.K = K; w.N = N; w.Nrows = Nrows; w.mode = mode; w.tile0 = t0; w.pad = 0; t0 += (K / 128) * (Nrows / 64); };
        auto fin = [&](int i) { add(p.ffn_w_in + (size_t)i * 1024 * 5632, WT_FFN_IN + (size_t)i * 5632 * 1024 * 2, 1024, 5632, 5632, 1); };
        auto fout = [&](int i) { add(p.ffn_w_out + (size_t)i * DFF * 1024, WT_FFN_OUT + (size_t)i * 1024 * DFF * 2, DFF, 1024, 1024, 0); };
        auto swa = [&](int i) { add(p.swa_w_in + (size_t)i * 1024 * 1536, WT_SWA_IN + (size_t)i * 1536 * 1024 * 2, 1024, 1536, 1536, 0);
                                add(p.swa_w_out + (size_t)i * 1024 * 1024, WT_SWA_OUT + (size_t)i * 1024 * 1024 * 2, 1024, 1024, 1024, 0); };
        int gi = 0;
        auto grp = [&]() { p.wg_desc[gi] = n; p.wg_tile[gi] = t0; ++gi; };
        grp(); fin(0); fout(0);
        grp(); swa(0); fin(1);
        grp(); fout(1); fin(2);
        grp(); fout(2); add(p.gdn_w_in, WT_GDN_IN, 1024, 6176, 6400, 0);
        grp(); add(p.gdn_w_out, WT_GDN_OUT, 2048, 1024, 1024, 0); fin(3);
        grp(); fout(3); fin(4);
        grp(); fout(4); add(p.hgrn_w_in, WT_HG_IN, 1024, 4096, 4096, 0); add(p.hgrn_w_out, WT_HG_OUT, 1024, 1024, 1024, 0);
        grp(); fin(5);
        grp(); fout(5); fin(6);
        grp(); fout(6); swa(1);
        grp(); fin(7);
        grp(); fout(7);
        grp();
        grp();
        p.wd_total = t0;
    }
    {
        int n = 0; p.prog[n++] = 0xF0; if (REP_PRO) p.prog[n++] = 0xF0;
        for (int l = 0; l < NLAYERS; ++l) for (int s = 0; s < 8; ++s) {
            if (s == 4 && (l % 3) != 1) continue;
            const bool is_resid = (s == 1 || s == 5 || s == 7), is_core = (s == 3 || s == 4);
            if (REP_GEMM && !is_core && ((REP_GEMM >> (is_resid ? 1 : (s == 2 ? 2 : 0))) & 1)) p.prog[n++] = (unsigned char)(l * 16 + s + (is_resid ? 0x40 : 0));
            if (is_core && ((REP_CORE >> ((l % 3) == 0 ? 0 : ((l % 3) == 2 ? 3 : (s == 3 ? 1 : 2)))) & 1)) p.prog[n++] = (unsigned char)(l * 16 + s);
            p.prog[n++] = (unsigned char)(l * 16 + s);
        }
        p.prog[n++] = 0xF1; p.nprog = n;
    }
#if MULTI_LAUNCH
    for (int ph = 0; ph < p.nprog; ++ph) hipLaunchKernelGGL(mega, dim3(grid_blocks), dim3(512), LDS_BYTES, stream, p, ph, ph + 1);
#else
    (void)hipMemsetAsync((unsigned char*)d_ws + OFF_BAR, 0, XCD_BAR_WORDS * 4, stream);
    int lo = 0, hi = p.nprog;
    void* args[] = {&p, &lo, &hi};
    hipError_t e = hipLaunchCooperativeKernel((const void*)mega, dim3(grid_blocks), dim3(512), args, LDS_BYTES, stream);
    if (e != hipSuccess) fprintf(stderr, "kernel_launch: cooperative launch failed: %s\n", hipGetErrorString(e));
#endif
}
```
